# Optimizing an MI355X kernel written in HIP

```python
import math
import jax, jax.numpy as jnp
from jax import lax
import numpy as np

D_MODEL = 1024
BATCH = 16
SEQ = 2048
DEPTH = 1

CHUNK = 64
Q_BLOCK = 128
D_MIX = D_MODEL
LRU_WIDTH = D_MIX // 2
LRU_BLOCKS = 8
LRU_BLOCK_W = LRU_WIDTH // LRU_BLOCKS
CONV_W = 4
LRU_C = 8.0
ATT_WIDTH = D_MIX - LRU_WIDTH
N_HEADS = 4
HEAD_DIM = ATT_WIDTH // (2 * N_HEADS)
V_DIM = 2 * HEAD_DIM
IN_COLS = 2 * LRU_WIDTH + 3 * ATT_WIDTH
N_GROUPS = 4
EXPERTS_PER_GROUP = 4
N_EXPERTS = N_GROUPS * EXPERTS_PER_GROUP
TOP_K_IN_GROUP = 2
D_EXPERT = D_MODEL // 2
EPS = 1e-6
NEG_BIG = -1e30

kernel_name = "hybrid_rglru_diffattn_hiermoe"


def rms_norm(x, g):
    xf = x.astype(jnp.float32)
    y = xf * lax.rsqrt(jnp.mean(xf * xf, axis=-1, keepdims=True) + EPS)
    return (y * g.astype(jnp.float32)).astype(x.dtype)


def alibi_slopes(n_heads):
    return jnp.exp2(-8.0 * jnp.arange(1, n_heads + 1, dtype=jnp.float32) / n_heads)


def causal_depthwise_conv(x, w, b):
    S = x.shape[1]
    xp = jnp.pad(x, ((0, 0), (CONV_W - 1, 0), (0, 0)))
    y = b
    for j in range(CONV_W):
        y = y + xp[:, j:j + S] * w[j]
    return y


def rg_lru(xc, w_a, b_a, w_x, b_x, lam):
    B, S, _ = xc.shape
    f32 = jnp.float32
    xf = xc.astype(f32)
    xb = xf.reshape(B, S, LRU_BLOCKS, LRU_BLOCK_W)
    r = jax.nn.sigmoid(jnp.einsum('bsnc,ncd->bsnd', xb, w_a.astype(f32)).reshape(B, S, LRU_WIDTH) + b_a.astype(f32))
    i = jax.nn.sigmoid(jnp.einsum('bsnc,ncd->bsnd', xb, w_x.astype(f32)).reshape(B, S, LRU_WIDTH) + b_x.astype(f32))
    log_a = -LRU_C * r * jax.nn.softplus(-lam.astype(f32))
    a = jnp.exp(log_a)
    u = jnp.sqrt(-jnp.expm1(2.0 * log_a)) * (i * xf)

    def combine(left, right):
        a1, b1 = left
        a2, b2 = right
        return a1 * a2, a2 * b1 + b2

    _, h = lax.associative_scan(combine, (a, u), axis=1)
    return h.astype(xc.dtype)


def diff_attention(q, k, v, lam, slopes):
    S = q.shape[1]
    f32 = jnp.float32
    scale = HEAD_DIM ** -0.5
    outs = []
    for blk in range(S // Q_BLOCK):
        q0 = blk * Q_BLOCK
        q1 = q0 + Q_BLOCK
        qb = q[:, q0:q1].astype(f32)
        kb = k[:, :q1].astype(f32)
        vb = v[:, :q1].astype(f32)
        s = jnp.einsum('bqhcd,bkhcd->bhcqk', qb, kb) * scale
        tq = jnp.arange(q0, q1)
        tk = jnp.arange(q1)
        dist = jnp.abs(tq[:, None] - tk[None, :]).astype(f32)
        allowed = (tk[None, :] // CHUNK) <= (tq[:, None] // CHUNK)
        bias = jnp.where(allowed[None], -slopes[:, None, None] * dist[None], NEG_BIG)
        p = jax.nn.softmax(s + bias[None, :, None], axis=-1)
        w = p[:, :, 0] - lam * p[:, :, 1]
        outs.append(jnp.einsum('bhqk,bkhe->bqhe', w, vb))
    return jnp.concatenate(outs, axis=1)


def hier_moe(xt, w_rg, b_rg, w_re, b_re, w_g, w_u, w_d):
    f32 = jnp.float32
    xf = xt.astype(f32)
    p_group = jax.nn.softmax(xf @ w_rg.astype(f32) + b_rg.astype(f32), axis=-1)
    g_gate, g_idx = lax.top_k(p_group, 1)
    e_logits = jnp.einsum('td,gde->tge', xf, w_re.astype(f32)) + b_re.astype(f32)
    sel = jnp.take_along_axis(e_logits, g_idx[:, :, None], axis=1)[:, 0]
    p_exp = jax.nn.softmax(sel, axis=-1)
    e_w, e_idx = lax.top_k(p_exp, TOP_K_IN_GROUP)
    e_w = e_w / jnp.sum(e_w, axis=-1, keepdims=True)
    gates = g_gate * e_w
    expert_id = g_idx * EXPERTS_PER_GROUP + e_idx
    dense_gates = jnp.einsum('tk,tke->te', gates, jax.nn.one_hot(expert_id, N_EXPERTS, dtype=f32))
    y = jnp.zeros_like(xf)
    for e in range(N_EXPERTS):
        hid = jax.nn.silu(xt @ w_g[e]) * (xt @ w_u[e])
        y = y + dense_gates[:, e:e + 1] * (hid @ w_d[e]).astype(f32)
    return y.astype(xt.dtype)


def setup_inputs(seed: int = 0) -> dict:
    key = jax.random.key(seed)
    ks = jax.random.split(key, 32)
    f32 = jnp.float32
    L = DEPTH

    def nrm(k, shape, std):
        return std * jax.random.normal(k, shape, f32)

    u = jax.random.uniform(ks[9], (L, LRU_WIDTH), f32, 0.9, 0.999)
    sig = u ** (1.0 / LRU_C)
    lru_lambda = jnp.log(sig) - jnp.log1p(-sig)
    return {
        'x': nrm(ks[0], (BATCH, SEQ, D_MODEL), 1.0),
        'norm1_g': 1.0 + nrm(ks[1], (L, D_MODEL), 0.02),
        'w_in': nrm(ks[2], (L, D_MODEL, IN_COLS), D_MODEL ** -0.5),
        'conv_w': nrm(ks[3], (L, CONV_W, LRU_WIDTH), CONV_W ** -0.5),
        'conv_b': nrm(ks[4], (L, LRU_WIDTH), 0.01),
        'w_gate_a': nrm(ks[5], (L, LRU_BLOCKS, LRU_BLOCK_W, LRU_BLOCK_W), LRU_BLOCK_W ** -0.5),
        'b_gate_a': nrm(ks[6], (L, LRU_WIDTH), 0.01),
        'w_gate_x': nrm(ks[7], (L, LRU_BLOCKS, LRU_BLOCK_W, LRU_BLOCK_W), LRU_BLOCK_W ** -0.5),
        'b_gate_x': nrm(ks[8], (L, LRU_WIDTH), 0.01),
        'lru_lambda': lru_lambda,
        'lru_out_g': 1.0 + nrm(ks[10], (L, LRU_WIDTH), 0.02),
        'q_norm_g': 1.0 + nrm(ks[11], (L, HEAD_DIM), 0.02),
        'k_norm_g': 1.0 + nrm(ks[12], (L, HEAD_DIM), 0.02),
        'lambda_q1': nrm(ks[13], (L, HEAD_DIM), 0.1),
        'lambda_k1': nrm(ks[14], (L, HEAD_DIM), 0.1),
        'lambda_q2': nrm(ks[15], (L, HEAD_DIM), 0.1),
        'lambda_k2': nrm(ks[16], (L, HEAD_DIM), 0.1),
        'sub_norm_g': 1.0 + nrm(ks[17], (L, V_DIM), 0.02),
        'w_out': nrm(ks[18], (L, D_MIX, D_MODEL), D_MIX ** -0.5),
        'norm2_g': 1.0 + nrm(ks[19], (L, D_MODEL), 0.02),
        'w_router_group': nrm(ks[20], (L, D_MODEL, N_GROUPS), D_MODEL ** -0.5),
        'b_router_group': nrm(ks[21], (L, N_GROUPS), 0.01),
        'w_router_expert': nrm(ks[22], (L, N_GROUPS, D_MODEL, EXPERTS_PER_GROUP), D_MODEL ** -0.5),
        'b_router_expert': nrm(ks[23], (L, N_GROUPS, EXPERTS_PER_GROUP), 0.01),
        'w_expert_gate': nrm(ks[24], (L, N_EXPERTS, D_MODEL, D_EXPERT), D_MODEL ** -0.5),
        'w_expert_up': nrm(ks[25], (L, N_EXPERTS, D_MODEL, D_EXPERT), D_MODEL ** -0.5),
        'w_expert_down': nrm(ks[26], (L, N_EXPERTS, D_EXPERT, D_MODEL), D_EXPERT ** -0.5),
    }


def reference(x, norm1_g, w_in, conv_w, conv_b, w_gate_a, b_gate_a, w_gate_x, b_gate_x,
              lru_lambda, lru_out_g, q_norm_g, k_norm_g, lambda_q1, lambda_k1, lambda_q2,
              lambda_k2, sub_norm_g, w_out, norm2_g, w_router_group, b_router_group,
              w_router_expert, b_router_expert, w_expert_gate, w_expert_up, w_expert_down):
    B, S, D = x.shape
    f32 = jnp.float32
    slopes = alibi_slopes(N_HEADS)
    splits = [LRU_WIDTH, 2 * LRU_WIDTH, 2 * LRU_WIDTH + ATT_WIDTH, 2 * LRU_WIDTH + 2 * ATT_WIDTH]
    h = x
    for l in range(DEPTH):
        lambda_init = 0.8 - 0.6 * math.exp(-0.3 * l)
        hn = rms_norm(h, norm1_g[l])
        proj = hn @ w_in[l]
        x_lru, g_lru, q, k, v = jnp.split(proj, splits, axis=-1)
        xc = causal_depthwise_conv(x_lru, conv_w[l], conv_b[l])
        y_lru = rg_lru(xc, w_gate_a[l], b_gate_a[l], w_gate_x[l], b_gate_x[l], lru_lambda[l]) * jax.nn.gelu(g_lru)
        y_lru = rms_norm(y_lru, lru_out_g[l])
        q = rms_norm(q.reshape(B, S, N_HEADS, 2, HEAD_DIM), q_norm_g[l])
        k = rms_norm(k.reshape(B, S, N_HEADS, 2, HEAD_DIM), k_norm_g[l])
        v = v.reshape(B, S, N_HEADS, V_DIM)
        lam = (jnp.exp(jnp.sum(lambda_q1[l].astype(f32) * lambda_k1[l].astype(f32)))
               - jnp.exp(jnp.sum(lambda_q2[l].astype(f32) * lambda_k2[l].astype(f32)))
               + lambda_init)
        o = diff_attention(q, k, v, lam, slopes)
        o = rms_norm(o, sub_norm_g[l]) * (1.0 - lambda_init)
        y_att = o.reshape(B, S, ATT_WIDTH).astype(h.dtype)
        h = h + jnp.concatenate([y_lru.astype(h.dtype), y_att], axis=-1) @ w_out[l]
        hn2 = rms_norm(h, norm2_g[l]).reshape(B * S, D)
        h = h + hier_moe(hn2, w_router_group[l], b_router_group[l], w_router_expert[l],
                         b_router_expert[l], w_expert_gate[l], w_expert_up[l],
                         w_expert_down[l]).reshape(B, S, D)
    return h
```

```cpp
#include <hip/hip_runtime.h>
#include <cstdio>
#include <cstdint>

#ifndef MK_N_LAUNCHES
#define MK_N_LAUNCHES 8
#endif
constexpr int N_LAUNCHES = MK_N_LAUNCHES;
constexpr int PER_PHASE = 8;

#define GAS __attribute__((address_space(1)))
#define LAS __attribute__((address_space(3)))
typedef unsigned short bf16;
typedef unsigned v4u __attribute__((ext_vector_type(4)));
typedef unsigned v2u __attribute__((ext_vector_type(2)));
typedef float f32x4 __attribute__((ext_vector_type(4)));
typedef GAS unsigned gu32;
#define RLX_AGENT __ATOMIC_RELAXED, __HIP_MEMORY_SCOPE_AGENT
#define LDS_WAIT() asm volatile("s_waitcnt lgkmcnt(0)" ::: "memory")
#define VM_WAIT() asm volatile("s_waitcnt vmcnt(0)" ::: "memory")

constexpr int BATCH = 16, SEQ = 2048, DM = 1024, T = BATCH * SEQ;
constexpr int LW = 512, AW = 512, NH = 4, HD = 64, VD = 128, INC = 2560;
constexpr int NE = 16, DE = 512, NBK = 24;
constexpr float EPS = 1e-6f;
constexpr float LOG2E = 1.4426950408889634f;
constexpr float C2 = 0.125f * LOG2E;
constexpr int NWAVES = 8, NTHR = 512;

constexpr size_t MiB = 1u << 20;
constexpr size_t WS_CTL = 0, CTL_ZERO_BYTES = 1 * MiB;
constexpr size_t WS_WIN = 2 * MiB;
constexpr size_t WS_WOUT = 8 * MiB;
constexpr size_t WS_WG = 10 * MiB;
constexpr size_t WS_WU = 26 * MiB;
constexpr size_t WS_WD = 42 * MiB;
constexpr size_t WS_AGG = 58 * MiB;
constexpr size_t WS_GATES = 60 * MiB;
constexpr size_t WS_LIST = 61 * MiB;
constexpr size_t WS_XN = 64 * MiB;
constexpr size_t WS_XL = 128 * MiB;
constexpr size_t WS_GL = 160 * MiB;
constexpr size_t WS_Q = 192 * MiB;
constexpr size_t WS_K = 224 * MiB;
constexpr size_t WS_V = 256 * MiB;
constexpr size_t WS_Y = 288 * MiB;
constexpr size_t WS_HID = 128 * MiB;
constexpr int HID_ROWS = T + NBK * 256;
constexpr size_t WS_END = 352 * MiB;
static_assert(WS_HID + (size_t)HID_ROWS * 2048 <= WS_K, "hid overlay");
constexpr int CW_TMO = 0, CW_BAR = 4096, CW_CNT = 8192;

constexpr int SCR_BYTES = 143360;
constexpr int LDSCTL_OFF = SCR_BYTES, MISC_OFF = LDSCTL_OFF + 320;
constexpr int LDS_BYTES = 147456;

__device__ __forceinline__ unsigned f2bf(float f) { unsigned u = __builtin_bit_cast(unsigned, f); return (u + 0x7fffu + ((u >> 16) & 1u)) >> 16; }
__device__ __forceinline__ unsigned pk2(float lo, float hi) { return f2bf(lo) | (f2bf(hi) << 16); }
__device__ __forceinline__ float bf2f(bf16 b) { return __builtin_bit_cast(float, (unsigned)b << 16); }
__device__ __forceinline__ float bflo(unsigned w) { return __builtin_bit_cast(float, w << 16); }
__device__ __forceinline__ float bfhi(unsigned w) { return __builtin_bit_cast(float, w & 0xffff0000u); }
__device__ __forceinline__ float wave_sum(float v) {
#pragma unroll
    for (int o = 1; o < 64; o <<= 1) v += __shfl_xor(v, o);
    return v;
}
__device__ __forceinline__ float sigmoidf_(float x) { return 1.0f / (1.0f + __expf(-x)); }
__device__ __forceinline__ float gelu_tanh(float x) {
    const float z = 0.7978845608028654f * (x + 0.044715f * x * x * x);
    const float e = __expf(2.0f * z);
    const float th = 1.0f - 2.0f / (e + 1.0f);
    return 0.5f * x * (1.0f + th);
}

#define XB_TMO      128
#define XB_XCNT(j)  (256  + 64 * (j))
#define XB_XSUB(j)  (1280 + 64 * (j))
#define XB_XGEN(j)  (2304 + 64 * (j))
#define XB_TOP      3328
#define XB_TOPGEN   3392
#define XCD_BAR_WORDS 3456
#define XB_SPIN_CAP (1u << 18)
__device__ __forceinline__ unsigned xb_ld(unsigned* p)              { return __hip_atomic_load(p, __ATOMIC_RELAXED, __HIP_MEMORY_SCOPE_AGENT); }
__device__ __forceinline__ unsigned xb_add(unsigned* p, unsigned v) { return __hip_atomic_fetch_add(p, v, __ATOMIC_RELAXED, __HIP_MEMORY_SCOPE_AGENT); }
__device__ __forceinline__ unsigned xb_xcc_id() { return (unsigned)__builtin_amdgcn_s_getreg((3 << 11) | 20) & 0xFu; }
#define XB_SPIN(cond, bar) do { unsigned _sp = 0; while (cond) { __builtin_amdgcn_s_sleep(1); \
    if ((++_sp & 255u) == 0u) { if (xb_ld(&(bar)[XB_TMO])) break; if (_sp > XB_SPIN_CAP) { atomicAdd(&(bar)[XB_TMO], 1u); break; } } } } while (0)
struct XcdBarrier { unsigned* bar; unsigned x; volatile LAS unsigned* st; };
__device__ __forceinline__ XcdBarrier xcd_barrier_post(unsigned* bar, volatile LAS unsigned* st) {
    XcdBarrier b; b.bar = bar; b.x = xb_xcc_id(); b.st = st;
    if (threadIdx.x == 0) (void)xb_add(&bar[XB_XCNT(b.x)], 1u);
    return b;
}
__device__ __forceinline__ void xcd_barrier_complete(unsigned* bar, unsigned x, unsigned& nloc, unsigned& nx) {
    const unsigned G = gridDim.x * gridDim.y * gridDim.z;
    unsigned sum, cnt, mine, sp = 0u;
    for (;;) {
        sum = 0u; cnt = 0u; mine = 0u;
#pragma unroll
        for (unsigned j = 0; j < 16; ++j) { const unsigned c = xb_ld(&bar[XB_XCNT(j)]); sum += c; cnt += (c > 0u) ? 1u : 0u; mine = (j == x) ? c : mine; }
        if (sum == G) break;
        __builtin_amdgcn_s_sleep(1);
        if ((++sp & 255u) == 0u) { if (xb_ld(&bar[XB_TMO])) break; if (sp > XB_SPIN_CAP) { atomicAdd(&bar[XB_TMO], 1u); break; } }
    }
    nloc = mine > 0u ? mine : 1u; nx = cnt > 0u ? cnt : 1u;
}
__device__ __forceinline__ void xcd_barrier(const XcdBarrier& b) {
    asm volatile("s_waitcnt vmcnt(0)" ::: "memory");
    __syncthreads();
    if (threadIdx.x == 0) {
        unsigned* bar = b.bar;
        __builtin_amdgcn_s_waitcnt(0);
        unsigned nloc = b.st[0], nx = b.st[1];
        if (nloc == 0u) { xcd_barrier_complete(bar, b.x, nloc, nx); b.st[0] = nloc; b.st[1] = nx; }
        const unsigned old = xb_add(&bar[XB_XSUB(b.x)], 1u);
        const unsigned gen = old / nloc;
        if (old + 1u == (gen + 1u) * nloc) {
            __builtin_amdgcn_fence(__ATOMIC_RELEASE, "agent");
            asm volatile("s_waitcnt vmcnt(0)" ::: "memory");
            const unsigned og = xb_add(&bar[XB_TOP], 1u);
            const unsigned tg = og / nx;
            if (og + 1u == (tg + 1u) * nx) xb_add(&bar[XB_TOPGEN], 1u);
            else XB_SPIN(xb_ld(&bar[XB_TOPGEN]) == tg, bar);
            __builtin_amdgcn_fence(__ATOMIC_ACQUIRE, "agent");
            xb_add(&bar[XB_XGEN(b.x)], 1u);
            asm volatile("s_waitcnt vmcnt(0)" ::: "memory");
        } else {
            XB_SPIN(xb_ld(&bar[XB_XGEN(b.x)]) == gen, bar);
            __builtin_amdgcn_fence(__ATOMIC_ACQUIRE, "agent");
            asm volatile("s_waitcnt vmcnt(0)" ::: "memory");
        }
    }
    __syncthreads();
}

struct Args { const float* in[27]; float* out; unsigned char* ws; int ph_lo, ph_hi, li, pad; };
struct Frame {
    LAS unsigned char* lds; volatile LAS unsigned* MISC; gu32* ctl;
    int tid, lane, wave, vcu, G;
    unsigned char* ws; float* out;
};

__device__ __forceinline__ void p0_transpose_item(const float* W, int K, int N, bf16* WT, LAS float* scr, int item, int lane) {
    const int nblk = N / 32, kb = item / nblk, nb = item % nblk, k0 = 64 * kb, n0 = 32 * nb;
#pragma unroll 8
    for (int i = 0; i < 32; ++i) { const int kk = 2 * i + (lane >> 5); scr[kk * 33 + (lane & 31)] = W[(size_t)(k0 + kk) * N + n0 + (lane & 31)]; }
    LDS_WAIT(); asm volatile("" ::: "memory");
    const int c = lane & 7;
#pragma unroll
    for (int j = 0; j < 4; ++j) { const int n = (lane >> 3) + 8 * j; const LAS float* s = scr + (8 * c) * 33 + n;
        v4u o; o.x = pk2(s[0 * 33], s[1 * 33]); o.y = pk2(s[2 * 33], s[3 * 33]); o.z = pk2(s[4 * 33], s[5 * 33]); o.w = pk2(s[6 * 33], s[7 * 33]);
        *(GAS v4u*)(WT + (size_t)(n0 + n) * K + k0 + 8 * c) = o; }
    LDS_WAIT(); asm volatile("" ::: "memory");
}
__device__ __forceinline__ void rms_row_to_bf16(const float* xrow, const float* g, bf16* orow, int lane) {
    const GAS f32x4* xr = (const GAS f32x4*)xrow + lane;
    const GAS f32x4* gr = (const GAS f32x4*)g + lane;
    f32x4 v[4]; float s = 0.f;
#pragma unroll
    for (int j = 0; j < 4; ++j) { v[j] = xr[64 * j]; s += (v[j].x * v[j].x + v[j].y * v[j].y) + (v[j].z * v[j].z + v[j].w * v[j].w); }
    const float r = 1.0f / sqrtf(wave_sum(s) * (1.0f / DM) + EPS);
    GAS v2u* o8 = (GAS v2u*)orow + lane;
#pragma unroll
    for (int j = 0; j < 4; ++j) { const f32x4 gg = gr[64 * j]; v2u w; w.x = pk2(v[j].x * r * gg.x, v[j].y * r * gg.y); w.y = pk2(v[j].z * r * gg.z, v[j].w * r * gg.w); o8[64 * j] = w; }
}
__device__ __forceinline__ void p0_prologue(Frame& F, const Args& a) {
    LAS float* scr = (LAS float*)(F.lds + F.wave * 16384);
    const int gw = F.vcu * NWAVES + F.wave, NGW = F.G * NWAVES;
    constexpr int I_IN = (DM / 64) * (INC / 32), I_OUT = (DM / 64) * (DM / 32), I_E = 256;
    constexpr int NITEMS = I_IN + I_OUT + 3 * NE * I_E;
    bf16* Win_t = (bf16*)(F.ws + WS_WIN); bf16* Wout_t = (bf16*)(F.ws + WS_WOUT);
    bf16* Wg_t = (bf16*)(F.ws + WS_WG); bf16* Wu_t = (bf16*)(F.ws + WS_WU); bf16* Wd_t = (bf16*)(F.ws + WS_WD);
    for (int it = gw; it < NITEMS; it += NGW) {
        int r = it;
        if (r < I_IN) { p0_transpose_item(a.in[2], DM, INC, Win_t, scr, r, F.lane); continue; } r -= I_IN;
        if (r < I_OUT) { p0_transpose_item(a.in[18], DM, DM, Wout_t, scr, r, F.lane); continue; } r -= I_OUT;
        if (r < NE * I_E) { const int e = r / I_E; p0_transpose_item(a.in[24] + (size_t)e * DM * DE, DM, DE, Wg_t + (size_t)e * DE * DM, scr, r % I_E, F.lane); continue; } r -= NE * I_E;
        if (r < NE * I_E) { const int e = r / I_E; p0_transpose_item(a.in[25] + (size_t)e * DM * DE, DM, DE, Wu_t + (size_t)e * DE * DM, scr, r % I_E, F.lane); continue; } r -= NE * I_E;
        { const int e = r / I_E; p0_transpose_item(a.in[26] + (size_t)e * DE * DM, DE, DM, Wd_t + (size_t)e * DM * DE, scr, r % I_E, F.lane); }
    }
    bf16* XN = (bf16*)(F.ws + WS_XN);
    for (int m = gw; m < T; m += NGW) rms_row_to_bf16(a.in[0] + (size_t)m * DM, a.in[1], XN + (size_t)m * DM, F.lane);
}

template <class AF, class BF>
__device__ __forceinline__ void ngemm_acc(LAS float* As, LAS float* Bs, int K, AF arow, BF bcol, float (&acc)[8]) {
    const int tid = threadIdx.x, r = tid >> 3, cg = tid & 7;
    const bf16* ap = arow(r); const bf16* bp = bcol(r);
    for (int k0 = 0; k0 < K; k0 += 64) {
        __syncthreads();
        const v4u va = *(const GAS v4u*)(ap + k0 + cg * 8);
        const v4u vb = *(const GAS v4u*)(bp + k0 + cg * 8);
#pragma unroll
        for (int j = 0; j < 4; ++j) {
            As[r * 65 + cg * 8 + 2 * j] = bflo(va[j]); As[r * 65 + cg * 8 + 2 * j + 1] = bfhi(va[j]);
            Bs[(cg * 8 + 2 * j) * 72 + r] = bflo(vb[j]); Bs[(cg * 8 + 2 * j + 1) * 72 + r] = bfhi(vb[j]);
        }
        __syncthreads();
#pragma unroll 8
        for (int kk = 0; kk < 64; ++kk) {
            const float av = As[r * 65 + kk];
            const f32x4 b0 = *(const LAS f32x4*)&Bs[kk * 72 + cg * 8], b1 = *(const LAS f32x4*)&Bs[kk * 72 + cg * 8 + 4];
            acc[0] += av * b0.x; acc[1] += av * b0.y; acc[2] += av * b0.z; acc[3] += av * b0.w;
            acc[4] += av * b1.x; acc[5] += av * b1.y; acc[6] += av * b1.z; acc[7] += av * b1.w;
        }
    }
}
__device__ __forceinline__ v4u pack8(const float (&v)[8]) { v4u o; o.x = pk2(v[0], v[1]); o.y = pk2(v[2], v[3]); o.z = pk2(v[4], v[5]); o.w = pk2(v[6], v[7]); return o; }
__device__ __forceinline__ float sum8lanes(float v) { v += __shfl_xor(v, 1); v += __shfl_xor(v, 2); v += __shfl_xor(v, 4); return v; }
__device__ __forceinline__ float max8lanes(float v) { v = fmaxf(v, __shfl_xor(v, 1)); v = fmaxf(v, __shfl_xor(v, 2)); v = fmaxf(v, __shfl_xor(v, 4)); return v; }

__device__ __forceinline__ void p1_simple(Frame& F, const Args& a) {
    LAS float* As = (LAS float*)F.lds; LAS float* Bs = As + 64 * 65;
    const bf16* XN = (const bf16*)(F.ws + WS_XN); const bf16* Win_t = (const bf16*)(F.ws + WS_WIN);
    const int tid = F.tid, r = tid >> 3, cg = tid & 7;
    constexpr int NCT = INC / 64;
    for (int tt = F.vcu; tt < (T / 64) * NCT; tt += F.G) {
        const int rt = tt / NCT, ct = tt % NCT;
        float acc[8] = {0.f, 0.f, 0.f, 0.f, 0.f, 0.f, 0.f, 0.f};
        ngemm_acc(As, Bs, DM, [&](int rr) { return XN + (size_t)(rt * 64 + rr) * DM; }, [&](int cc) { return Win_t + (size_t)(ct * 64 + cc) * DM; }, acc);
        const int region = ct >> 3, lc0 = (ct & 7) * 64 + cg * 8; const size_t row = (size_t)rt * 64 + r;
        bf16* dst = (bf16*)(F.ws + WS_XL + (size_t)region * 32 * MiB) + row * 512 + lc0;
        if (region == 1) {
#pragma unroll
            for (int j = 0; j < 8; ++j) acc[j] = gelu_tanh(acc[j]);
        } else if (region == 2 || region == 3) {
            float ss = 0.f;
#pragma unroll
            for (int j = 0; j < 8; ++j) ss += acc[j] * acc[j];
            ss = sum8lanes(ss);
            const float rr = (1.0f / sqrtf(ss * (1.0f / HD) + EPS)) * (region == 2 ? C2 : 1.0f);
            const float* g = a.in[region == 2 ? 11 : 12] + cg * 8;
#pragma unroll
            for (int j = 0; j < 8; ++j) acc[j] = acc[j] * rr * g[j];
        }
        *(GAS v4u*)dst = pack8(acc);
    }
}

template <bool APPLY>
__device__ __forceinline__ void lru_chunk(Frame& F, const Args& a, int b, int j) {
    LAS float* XC = (LAS float*)F.lds;
    const int ch = F.tid; const size_t row0 = (size_t)b * SEQ + (size_t)j * 64;
    const bf16* XL = (const bf16*)(F.ws + WS_XL); const bf16* GL = (const bf16*)(F.ws + WS_GL);
    float* AGG = (float*)(F.ws + WS_AGG);
    __syncthreads();
    {
        const float cw0 = a.in[3][ch], cw1 = a.in[3][512 + ch], cw2 = a.in[3][1024 + ch], cw3 = a.in[3][1536 + ch], cb = a.in[4][ch];
        float x0 = 0.f, x1 = 0.f, x2 = 0.f;
        if (j > 0) { x0 = bf2f(XL[(row0 - 3) * 512 + ch]); x1 = bf2f(XL[(row0 - 2) * 512 + ch]); x2 = bf2f(XL[(row0 - 1) * 512 + ch]); }
#pragma unroll 8
        for (int t = 0; t < 64; ++t) {
            const float x3 = bf2f(XL[(row0 + t) * 512 + ch]);
            XC[t * 512 + ch] = cb + cw0 * x0 + cw1 * x1 + cw2 * x2 + cw3 * x3;
            x0 = x1; x1 = x2; x2 = x3;
        }
    }
    __syncthreads();
    float ra[64], ri[64];
#pragma unroll
    for (int t = 0; t < 64; ++t) { ra[t] = 0.f; ri[t] = 0.f; }
    {
        const int blk = ch >> 6, d = ch & 63;
        const float* Wa = a.in[5] + blk * 4096 + d; const float* Wx = a.in[7] + blk * 4096 + d;
        const LAS float* xb = XC + blk * 64;
#pragma unroll 1
        for (int c = 0; c < 64; c += 4) {
            const float wa0 = Wa[(c + 0) * 64], wa1 = Wa[(c + 1) * 64], wa2 = Wa[(c + 2) * 64], wa3 = Wa[(c + 3) * 64];
            const float wx0 = Wx[(c + 0) * 64], wx1 = Wx[(c + 1) * 64], wx2 = Wx[(c + 2) * 64], wx3 = Wx[(c + 3) * 64];
#pragma unroll
            for (int t = 0; t < 64; ++t) {
                const f32x4 xv = *(const LAS f32x4*)&xb[t * 512 + c];
                ra[t] += xv.x * wa0 + xv.y * wa1 + xv.z * wa2 + xv.w * wa3;
                ri[t] += xv.x * wx0 + xv.y * wx1 + xv.z * wx2 + xv.w * wx3;
            }
        }
    }
    __syncthreads();
    const float sp = log1pf(expf(-a.in[9][ch]));
    const float ba = a.in[6][ch], bx = a.in[8][ch];
    float h = 0.f, lasum = 0.f;
    if (APPLY) {
        for (int i = 0; i < j; ++i) { const float A = AGG[((size_t)(b * 32 + i) * 2 + 0) * 512 + ch], H = AGG[((size_t)(b * 32 + i) * 2 + 1) * 512 + ch]; h = A * h + H; }
    }
#pragma unroll
    for (int t = 0; t < 64; ++t) {
        const float xc = XC[t * 512 + ch];
        const float rg = sigmoidf_(ra[t] + ba), ig = sigmoidf_(ri[t] + bx);
        const float la = -8.0f * rg * sp;
        const float av = expf(la);
        const float u = sqrtf(-expm1f(2.0f * la)) * (ig * xc);
        h = av * h + u;
        if (APPLY) XC[t * 512 + ch] = h * bf2f(GL[(row0 + t) * 512 + ch]);
        else lasum += la;
    }
    if (!APPLY) {
        AGG[((size_t)(b * 32 + j) * 2 + 0) * 512 + ch] = expf(lasum);
        AGG[((size_t)(b * 32 + j) * 2 + 1) * 512 + ch] = h;
        return;
    }
    __syncthreads();
    bf16* Y = (bf16*)(F.ws + WS_Y);
    const f32x4 g0 = *(const GAS f32x4*)(a.in[10] + F.lane * 8), g1 = *(const GAS f32x4*)(a.in[10] + F.lane * 8 + 4);
#pragma unroll
    for (int i = 0; i < 8; ++i) {
        const int t = F.wave + 8 * i;
        const f32x4 y0 = *(const LAS f32x4*)&XC[t * 512 + F.lane * 8], y1 = *(const LAS f32x4*)&XC[t * 512 + F.lane * 8 + 4];
        float ss = (y0.x * y0.x + y0.y * y0.y) + (y0.z * y0.z + y0.w * y0.w) + (y1.x * y1.x + y1.y * y1.y) + (y1.z * y1.z + y1.w * y1.w);
        const float r = 1.0f / sqrtf(wave_sum(ss) * (1.0f / LW) + EPS);
        v4u o; o.x = pk2(y0.x * r * g0.x, y0.y * r * g0.y); o.y = pk2(y0.z * r * g0.z, y0.w * r * g0.w); o.z = pk2(y1.x * r * g1.x, y1.y * r * g1.y); o.w = pk2(y1.z * r * g1.z, y1.w * r * g1.w);
        *(GAS v4u*)(Y + (row0 + t) * DM + F.lane * 8) = o;
    }
}

__device__ __forceinline__ void nattn_unit(Frame& F, const Args& a, int b, int h, int c, float lam) {
    LAS float* Qs = (LAS float*)F.lds; LAS float* Ks = Qs + 64 * 132; LAS float* Vs = Ks + 64 * 132; LAS float* Ps = Vs + 64 * 132;
    const bf16* Qg = (const bf16*)(F.ws + WS_Q); const bf16* Kg = (const bf16*)(F.ws + WS_K); const bf16* Vg = (const bf16*)(F.ws + WS_V);
    const int tid = F.tid, qi = tid >> 3, sub = tid & 7;
    const float slope2 = exp2f(-2.0f * (float)(h + 1)) * LOG2E;
    __syncthreads();
    {
        const bf16* src = Qg + ((size_t)b * SEQ + 64 * c + qi) * 512 + h * 128 + sub * 16;
        const v4u v0 = *(const GAS v4u*)src, v1 = *(const GAS v4u*)(src + 8);
        LAS float* d = Qs + qi * 132 + sub * 16;
#pragma unroll
        for (int i = 0; i < 4; ++i) { d[2 * i] = bflo(v0[i]); d[2 * i + 1] = bfhi(v0[i]); d[8 + 2 * i] = bflo(v1[i]); d[8 + 2 * i + 1] = bfhi(v1[i]); }
    }
    float m0 = -1e30f, m1 = -1e30f, l0 = 0.f, l1 = 0.f, O0[16], O1[16];
#pragma unroll
    for (int i = 0; i < 16; ++i) { O0[i] = 0.f; O1[i] = 0.f; }
    for (int kt = 0; kt <= c; ++kt) {
        __syncthreads();
        {
            const size_t off = ((size_t)b * SEQ + 64 * kt + qi) * 512 + h * 128 + sub * 16;
            const v4u k0 = *(const GAS v4u*)(Kg + off), k1 = *(const GAS v4u*)(Kg + off + 8);
            const v4u v0 = *(const GAS v4u*)(Vg + off), v1 = *(const GAS v4u*)(Vg + off + 8);
            LAS float* dk = Ks + qi * 132 + sub * 16; LAS float* dv = Vs + qi * 132 + sub * 16;
#pragma unroll
            for (int i = 0; i < 4; ++i) {
                dk[2 * i] = bflo(k0[i]); dk[2 * i + 1] = bfhi(k0[i]); dk[8 + 2 * i] = bflo(k1[i]); dk[8 + 2 * i + 1] = bfhi(k1[i]);
                dv[2 * i] = bflo(v0[i]); dv[2 * i + 1] = bfhi(v0[i]); dv[8 + 2 * i] = bflo(v1[i]); dv[8 + 2 * i + 1] = bfhi(v1[i]);
            }
        }
        __syncthreads();
        float e0[8], e1[8];
#pragma unroll
        for (int j = 0; j < 8; ++j) {
            const int kk = sub + 8 * j;
            float s0 = 0.f, s1 = 0.f;
#pragma unroll
            for (int d = 0; d < 64; d += 4) {
                const f32x4 q0 = *(const LAS f32x4*)&Qs[qi * 132 + d], k0 = *(const LAS f32x4*)&Ks[kk * 132 + d];
                const f32x4 q1 = *(const LAS f32x4*)&Qs[qi * 132 + 64 + d], k1 = *(const LAS f32x4*)&Ks[kk * 132 + 64 + d];
                s0 += (q0.x * k0.x + q0.y * k0.y) + (q0.z * k0.z + q0.w * k0.w);
                s1 += (q1.x * k1.x + q1.y * k1.y) + (q1.z * k1.z + q1.w * k1.w);
            }
            const int dist = (64 * c + qi) - (64 * kt + kk);
            const float bias = -slope2 * (float)(dist < 0 ? -dist : dist);
            e0[j] = s0 + bias; e1[j] = s1 + bias;
        }
        {
            float tm = e0[0];
#pragma unroll
            for (int j = 1; j < 8; ++j) tm = fmaxf(tm, e0[j]);
            tm = max8lanes(tm);
            const float mn = fmaxf(m0, tm), al = exp2f(m0 - mn);
            float ps = 0.f;
#pragma unroll
            for (int j = 0; j < 8; ++j) { const float p = exp2f(e0[j] - mn); ps += p; Ps[qi * 65 + sub + 8 * j] = p; }
            ps = sum8lanes(ps);
            l0 = l0 * al + ps; m0 = mn;
#pragma unroll
            for (int i = 0; i < 16; ++i) O0[i] *= al;
        }
        {
            float tm = e1[0];
#pragma unroll
            for (int j = 1; j < 8; ++j) tm = fmaxf(tm, e1[j]);
            tm = max8lanes(tm);
            const float mn = fmaxf(m1, tm), al = exp2f(m1 - mn);
            float ps = 0.f;
#pragma unroll
            for (int j = 0; j < 8; ++j) { const float p = exp2f(e1[j] - mn); ps += p; Ps[(64 + qi) * 65 + sub + 8 * j] = p; }
            ps = sum8lanes(ps);
            l1 = l1 * al + ps; m1 = mn;
#pragma unroll
            for (int i = 0; i < 16; ++i) O1[i] *= al;
        }
        __syncthreads();
#pragma unroll 4
        for (int kk = 0; kk < 64; ++kk) {
            const float p0 = Ps[qi * 65 + kk], p1 = Ps[(64 + qi) * 65 + kk];
            const LAS f32x4* vp = (const LAS f32x4*)&Vs[kk * 132 + sub * 16];
#pragma unroll
            for (int q = 0; q < 4; ++q) { const f32x4 v = vp[q];
                O0[4 * q] += p0 * v.x; O0[4 * q + 1] += p0 * v.y; O0[4 * q + 2] += p0 * v.z; O0[4 * q + 3] += p0 * v.w;
                O1[4 * q] += p1 * v.x; O1[4 * q + 1] += p1 * v.y; O1[4 * q + 2] += p1 * v.z; O1[4 * q + 3] += p1 * v.w; }
        }
    }
    const float il0 = 1.0f / l0, il1 = lam / l1;
    float o[16], ss = 0.f;
#pragma unroll
    for (int i = 0; i < 16; ++i) { o[i] = O0[i] * il0 - O1[i] * il1; ss += o[i] * o[i]; }
    ss = sum8lanes(ss);
    const float r = (1.0f / sqrtf(ss * (1.0f / VD) + EPS)) * 0.8f;
    const float* sg = a.in[17] + sub * 16;
    float o8a[8], o8b[8];
#pragma unroll
    for (int i = 0; i < 8; ++i) { o8a[i] = o[i] * r * sg[i]; o8b[i] = o[8 + i] * r * sg[8 + i]; }
    bf16* dst = (bf16*)(F.ws + WS_Y) + ((size_t)b * SEQ + 64 * c + qi) * DM + 512 + h * 128 + sub * 16;
    *(GAS v4u*)dst = pack8(o8a); *(GAS v4u*)(dst + 8) = pack8(o8b);
}
__device__ __forceinline__ float diff_lambda(const Args& a) {
    float s1 = 0.f, s2 = 0.f;
    for (int i = 0; i < HD; ++i) { s1 += a.in[13][i] * a.in[14][i]; s2 += a.in[15][i] * a.in[16][i]; }
    return expf(s1) - expf(s2) + 0.2f;
}
__device__ __forceinline__ void p3_simple(Frame& F, const Args& a) {
    const float lam = diff_lambda(a);
    for (int i = F.vcu; i < BATCH * NH * 32; i += F.G) { const int c = 31 - (i >> 6), bh = i & 63; nattn_unit(F, a, bh >> 2, bh & 3, c, lam); }
    for (int i = F.vcu; i < BATCH * 32; i += F.G) lru_chunk<true>(F, a, i >> 5, i & 31);
}

__device__ __forceinline__ void p4_simple(Frame& F, const Args& a) {
    LAS float* As = (LAS float*)F.lds; LAS float* Bs = As + 64 * 65;
    const bf16* Y = (const bf16*)(F.ws + WS_Y); const bf16* Wout_t = (const bf16*)(F.ws + WS_WOUT);
    const int tid = F.tid, r = tid >> 3, cg = tid & 7;
    for (int tt = F.vcu; tt < (T / 64) * 16; tt += F.G) {
        const int rt = tt >> 4, ct = tt & 15;
        float acc[8] = {0.f, 0.f, 0.f, 0.f, 0.f, 0.f, 0.f, 0.f};
        ngemm_acc(As, Bs, DM, [&](int rr) { return Y + (size_t)(rt * 64 + rr) * DM; }, [&](int cc) { return Wout_t + (size_t)(ct * 64 + cc) * DM; }, acc);
        const size_t off = ((size_t)rt * 64 + r) * DM + ct * 64 + cg * 8;
        const f32x4 x0 = *(const GAS f32x4*)(a.in[0] + off), x1 = *(const GAS f32x4*)(a.in[0] + off + 4);
        *(GAS f32x4*)(F.out + off) = (f32x4){x0.x + acc[0], x0.y + acc[1], x0.z + acc[2], x0.w + acc[3]};
        *(GAS f32x4*)(F.out + off + 4) = (f32x4){x1.x + acc[4], x1.y + acc[5], x1.z + acc[6], x1.w + acc[7]};
    }
}

__device__ __forceinline__ void p5_route(Frame& F, const Args& a) {
    LAS float* Wr = (LAS float*)F.lds;
    __syncthreads();
    for (int i = F.tid; i < 20 * 1024; i += NTHR) {
        const int c = i >> 10, k = i & 1023;
        Wr[i] = (c < 4) ? a.in[20][k * 4 + c] : a.in[22][((size_t)((c - 4) >> 2) * 1024 + k) * 4 + ((c - 4) & 3)];
    }
    __syncthreads();
    const int gw = F.vcu * NWAVES + F.wave, NGW = F.G * NWAVES, lane = F.lane;
    bf16* HN2 = (bf16*)(F.ws + WS_XN); float* gates = (float*)(F.ws + WS_GATES); int* list = (int*)(F.ws + WS_LIST);
    const GAS f32x4* gr = (const GAS f32x4*)a.in[19] + lane;
    for (int m = gw; m < T; m += NGW) {
        const GAS f32x4* xr = (const GAS f32x4*)(F.out + (size_t)m * DM) + lane;
        f32x4 v[4]; float s = 0.f;
#pragma unroll
        for (int j = 0; j < 4; ++j) { v[j] = xr[64 * j]; s += (v[j].x * v[j].x + v[j].y * v[j].y) + (v[j].z * v[j].z + v[j].w * v[j].w); }
        const float r = 1.0f / sqrtf(wave_sum(s) * (1.0f / DM) + EPS);
        GAS v2u* o8 = (GAS v2u*)(HN2 + (size_t)m * DM) + lane;
#pragma unroll
        for (int j = 0; j < 4; ++j) { const f32x4 gg = gr[64 * j]; v[j].x *= r * gg.x; v[j].y *= r * gg.y; v[j].z *= r * gg.z; v[j].w *= r * gg.w;
            v2u w; w.x = pk2(v[j].x, v[j].y); w.y = pk2(v[j].z, v[j].w); o8[64 * j] = w; }
        float lg[20];
#pragma unroll
        for (int c = 0; c < 20; ++c) {
            float acc = 0.f;
#pragma unroll
            for (int j = 0; j < 4; ++j) { const f32x4 w = *(const LAS f32x4*)&Wr[c * 1024 + 256 * j + 4 * lane]; acc += (v[j].x * w.x + v[j].y * w.y) + (v[j].z * w.z + v[j].w * w.w); }
            lg[c] = wave_sum(acc);
            asm volatile("" ::: "memory");
        }
        float gl0 = lg[0] + a.in[21][0], gl1 = lg[1] + a.in[21][1], gl2 = lg[2] + a.in[21][2], gl3 = lg[3] + a.in[21][3];
        int gi = 0; float gm = gl0;
        if (gl1 > gm) { gm = gl1; gi = 1; } if (gl2 > gm) { gm = gl2; gi = 2; } if (gl3 > gm) { gm = gl3; gi = 3; }
        const float pg = 1.0f / (expf(gl0 - gm) + expf(gl1 - gm) + expf(gl2 - gm) + expf(gl3 - gm));
        float el[4];
#pragma unroll
        for (int e = 0; e < 4; ++e) { const float sel = gi == 0 ? lg[4 + e] : gi == 1 ? lg[8 + e] : gi == 2 ? lg[12 + e] : lg[16 + e]; el[e] = sel + a.in[23][gi * 4 + e]; }
        int e1 = 0; float v1 = el[0];
#pragma unroll
        for (int e = 1; e < 4; ++e) if (el[e] > v1) { v1 = el[e]; e1 = e; }
        int e2 = -1; float v2 = -3.0e38f;
#pragma unroll
        for (int e = 0; e < 4; ++e) if (e != e1 && el[e] > v2) { v2 = el[e]; e2 = e; }
        const float w1 = 1.0f / (1.0f + expf(v2 - v1)), w2 = 1.0f - w1;
        const int lo = e1 < e2 ? e1 : e2, hi = e1 < e2 ? e2 : e1;
        const float glo = pg * (e1 < e2 ? w1 : w2), ghi = pg * (e1 < e2 ? w2 : w1);
        const int pi = lo == 0 ? hi - 1 : (lo == 1 ? hi + 1 : 5);
        const int bk = gi * 6 + pi;
        if (lane == 0) {
            const unsigned slot = __hip_atomic_fetch_add((unsigned*)(F.ctl + CW_CNT + bk), 1u, RLX_AGENT);
            list[(size_t)bk * T + slot] = m; gates[2 * (size_t)m] = glo; gates[2 * (size_t)m + 1] = ghi;
        }
    }
}

__device__ __forceinline__ void bucket_tables(Frame& F, LAS int* tb) {
    __syncthreads();
    if (F.tid == 0) {
        int off = 0, pre = 0;
        for (int k = 0; k < NBK; ++k) {
            const int c = (int)__hip_atomic_load((unsigned*)(F.ctl + CW_CNT + k), RLX_AGENT);
            tb[k] = c; tb[24 + k] = off; tb[49 + k] = pre; off += (c + 255) & ~255; pre += (c + 63) >> 6;
        }
        tb[24 + 24] = off; tb[49 + 24] = pre;
    }
    __syncthreads();
}
__device__ __forceinline__ void bk_experts(int bk, int& elo, int& ehi) {
    const int g = bk / 6, pi = bk % 6;
    const int lo = pi < 3 ? 0 : (pi < 5 ? 1 : 2), hi = pi < 3 ? pi + 1 : (pi < 5 ? pi - 1 : 3);
    elo = g * 4 + lo; ehi = g * 4 + hi;
}

__device__ __forceinline__ void p6_simple(Frame& F, const Args& a) {
    LAS float* As = (LAS float*)F.lds; LAS float* Bs = As + 64 * 65; LAS int* tb = (LAS int*)(Bs + 64 * 72);
    bucket_tables(F, tb);
    const bf16* HN2 = (const bf16*)(F.ws + WS_XN); const bf16* Wg_t = (const bf16*)(F.ws + WS_WG); const bf16* Wu_t = (const bf16*)(F.ws + WS_WU);
    const float* gates = (const float*)(F.ws + WS_GATES); const int* list = (const int*)(F.ws + WS_LIST);
    bf16* HID = (bf16*)(F.ws + WS_HID);
    const int tid = F.tid, r = tid >> 3, cg = tid & 7;
    const int ntile = tb[49 + 24];
    for (int u = F.vcu; u < ntile * 16; u += F.G) {
        const int tile = u >> 4, x = (u >> 3) & 1, jt = u & 7;
        int bk = 0;
        for (int k = 1; k < NBK; ++k) if (tile >= tb[49 + k]) bk = k;
        const int rt = tile - tb[49 + bk], cnt = tb[bk], off = tb[24 + bk];
        int elo, ehi; bk_experts(bk, elo, ehi); const int e = x ? ehi : elo;
        const int idx = rt * 64 + r; const bool valid = idx < cnt;
        const int tok = list[(size_t)bk * T + (valid ? idx : 0)];
        const float gate = valid ? gates[2 * (size_t)tok + x] : 0.f;
        float ag[8] = {0.f, 0.f, 0.f, 0.f, 0.f, 0.f, 0.f, 0.f}, au[8] = {0.f, 0.f, 0.f, 0.f, 0.f, 0.f, 0.f, 0.f};
        ngemm_acc(As, Bs, DM, [&](int) { return HN2 + (size_t)tok * DM; }, [&](int cc) { return Wg_t + ((size_t)e * DE + jt * 64 + cc) * DM; }, ag);
        ngemm_acc(As, Bs, DM, [&](int) { return HN2 + (size_t)tok * DM; }, [&](int cc) { return Wu_t + ((size_t)e * DE + jt * 64 + cc) * DM; }, au);
        float hv[8];
#pragma unroll
        for (int j = 0; j < 8; ++j) hv[j] = ag[j] * sigmoidf_(ag[j]) * au[j] * gate;
        *(GAS v4u*)(HID + (size_t)(off + idx) * DM + x * 512 + jt * 64 + cg * 8) = pack8(hv);
    }
}
__device__ __forceinline__ void p7_simple(Frame& F, const Args& a) {
    LAS float* As = (LAS float*)F.lds; LAS float* Bs = As + 64 * 65; LAS int* tb = (LAS int*)(Bs + 64 * 72);
    bucket_tables(F, tb);
    const bf16* HID = (const bf16*)(F.ws + WS_HID); const bf16* Wd_t = (const bf16*)(F.ws + WS_WD);
    const int* list = (const int*)(F.ws + WS_LIST);
    const int tid = F.tid, r = tid >> 3, cg = tid & 7;
    const int ntile = tb[49 + 24];
    for (int u = F.vcu; u < ntile * 16; u += F.G) {
        const int tile = u >> 4, ct = u & 15;
        int bk = 0;
        for (int k = 1; k < NBK; ++k) if (tile >= tb[49 + k]) bk = k;
        const int rt = tile - tb[49 + bk], cnt = tb[bk], off = tb[24 + bk];
        int elo, ehi; bk_experts(bk, elo, ehi);
        const int idx = rt * 64 + r; const bool valid = idx < cnt;
        float acc[8] = {0.f, 0.f, 0.f, 0.f, 0.f, 0.f, 0.f, 0.f};
        ngemm_acc(As, Bs, DE, [&](int rr) { return HID + (size_t)(off + rt * 64 + rr) * DM; }, [&](int cc) { return Wd_t + ((size_t)elo * DM + ct * 64 + cc) * DE; }, acc);
        ngemm_acc(As, Bs, DE, [&](int rr) { return HID + (size_t)(off + rt * 64 + rr) * DM + 512; }, [&](int cc) { return Wd_t + ((size_t)ehi * DM + ct * 64 + cc) * DE; }, acc);
        if (valid) {
            const int tok = list[(size_t)bk * T + idx];
            const size_t o = (size_t)tok * DM + ct * 64 + cg * 8;
            const f32x4 h0 = *(const GAS f32x4*)(F.out + o), h1 = *(const GAS f32x4*)(F.out + o + 4);
            *(GAS f32x4*)(F.out + o) = (f32x4){h0.x + acc[0], h0.y + acc[1], h0.z + acc[2], h0.w + acc[3]};
            *(GAS f32x4*)(F.out + o + 4) = (f32x4){h1.x + acc[4], h1.y + acc[5], h1.z + acc[6], h1.w + acc[7]};
        }
    }
}

__global__ void __launch_bounds__(NTHR, 2) fwd_kernel(Args args) {
    extern __shared__ __attribute__((aligned(16))) unsigned char lds[];
    Frame F;
    F.lds = (LAS unsigned char*)lds;
    F.MISC = (volatile LAS unsigned*)(F.lds + MISC_OFF);
    F.tid = threadIdx.x; F.lane = F.tid & 63; F.wave = __builtin_amdgcn_readfirstlane(F.tid >> 6);
    F.G = gridDim.x; { const int bx = blockIdx.x; F.vcu = (F.G % 8 == 0) ? (bx % 8) * (F.G / 8) + bx / 8 : bx; }
    F.ws = args.ws; F.out = args.out; F.ctl = (gu32*)(args.ws + WS_CTL);
    for (int u = F.tid; u < (LDS_BYTES - LDSCTL_OFF) / 4; u += NTHR) ((LAS unsigned*)(F.lds + LDSCTL_OFF))[u] = 0u;
    __syncthreads();
    XcdBarrier bar; bar.bar = (unsigned*)(F.ctl + CW_BAR); bar.x = 0; bar.st = nullptr;
    if (N_LAUNCHES != PER_PHASE) bar = xcd_barrier_post((unsigned*)(F.ctl + CW_BAR), F.MISC + 8);
#define GRID_BAR() do { if (N_LAUNCHES != PER_PHASE) xcd_barrier(bar); } while (0)
    const int lo = args.ph_lo, hi = args.ph_hi;
#define IN(k) (lo <= (k) && (k) < hi)
#define BOTH(k) (IN(k) && IN((k) + 1))
    if (IN(0)) { p0_prologue(F, args); if (BOTH(0)) GRID_BAR(); }
    if (IN(1)) { p1_simple(F, args); if (BOTH(1)) GRID_BAR(); }
    if (IN(2)) { for (int i = F.vcu; i < BATCH * 32; i += F.G) lru_chunk<false>(F, args, i >> 5, i & 31); if (BOTH(2)) GRID_BAR(); }
    if (IN(3)) { p3_simple(F, args); if (BOTH(3)) GRID_BAR(); }
    if (IN(4)) { p4_simple(F, args); if (BOTH(4)) GRID_BAR(); }
    if (IN(5)) { p5_route(F, args); if (BOTH(5)) GRID_BAR(); }
    if (IN(6)) { p6_simple(F, args); if (BOTH(6)) GRID_BAR(); }
    if (IN(7)) { p7_simple(F, args); }
#undef IN
#undef BOTH
}

extern "C" void kernel_launch(void* const* d_in, const int* in_sizes, int n_in, void* d_out, int out_size, void* d_ws, size_t ws_size, hipStream_t stream) {
    static int grid = 0;
    if (grid == 0) {
        if (n_in != 27 || in_sizes[0] != T * DM || out_size != T * DM || ws_size < WS_END) {
            fprintf(stderr, "kernel_launch: unexpected shapes (n_in %d, in0 %d, out %d, ws %zu); nothing launched\n", n_in, n_in > 0 ? in_sizes[0] : -1, out_size, ws_size); grid = -1; return; }
        int dev = 0, cus = 0;
        if (hipGetDevice(&dev) != hipSuccess || hipDeviceGetAttribute(&cus, hipDeviceAttributeMultiprocessorCount, dev) != hipSuccess) { grid = -1; return; }
        if (hipFuncSetAttribute((const void*)fwd_kernel, hipFuncAttributeMaxDynamicSharedMemorySize, LDS_BYTES) != hipSuccess) { fprintf(stderr, "kernel_launch: hipFuncSetAttribute failed\n"); grid = -1; return; }
        (void)hipGetLastError();
        grid = cus;
    }
    if (grid < 0) return;
    if (hipMemsetAsync((char*)d_ws + WS_CTL, 0, CTL_ZERO_BYTES, stream) != hipSuccess) return;
    Args a{};
    for (int i = 0; i < 27; ++i) a.in[i] = (const float*)d_in[i];
    a.out = (float*)d_out; a.ws = (unsigned char*)d_ws;
    for (int li = 0; li < N_LAUNCHES; ++li) {
        a.ph_lo = (N_LAUNCHES == PER_PHASE) ? li : 0; a.ph_hi = (N_LAUNCHES == PER_PHASE) ? li + 1 : PER_PHASE; a.li = li;
        hipLaunchKernelGGL(fwd_kernel, dim3(grid), dim3(NTHR), LDS_BYTES, stream, a);
    }
}
```

```cpp
#include <hip/hip_runtime.h>
#include <cstdio>
#include <cstdint>

#ifndef MK_N_LAUNCHES
#define MK_N_LAUNCHES 1
#endif
constexpr int N_LAUNCHES = MK_N_LAUNCHES;
constexpr int PER_PHASE = 8;

#define GAS __attribute__((address_space(1)))
#define LAS __attribute__((address_space(3)))
typedef unsigned short bf16;
typedef unsigned v4u __attribute__((ext_vector_type(4)));
typedef unsigned v2u __attribute__((ext_vector_type(2)));
typedef float f32x4 __attribute__((ext_vector_type(4)));
typedef GAS unsigned gu32;
#define RLX_AGENT __ATOMIC_RELAXED, __HIP_MEMORY_SCOPE_AGENT
#define LDS_WAIT() asm volatile("s_waitcnt lgkmcnt(0)" ::: "memory")
#define VM_WAIT() asm volatile("s_waitcnt vmcnt(0)" ::: "memory")

constexpr int BATCH = 16, SEQ = 2048, DM = 1024, T = BATCH * SEQ;
constexpr int LW = 512, AW = 512, NH = 4, HD = 64, VD = 128, INC = 2560;
constexpr int NE = 16, DE = 512, NBK = 24;
constexpr float EPS = 1e-6f;
constexpr float LOG2E = 1.4426950408889634f;
constexpr float C2 = 0.125f * LOG2E;
constexpr int NWAVES = 8, NTHR = 512;

constexpr size_t MiB = 1u << 20;
constexpr size_t WS_CTL = 0, CTL_ZERO_BYTES = 1 * MiB;
constexpr size_t WS_WIN = 2 * MiB;
constexpr size_t WS_WOUT = 8 * MiB;
constexpr size_t WS_WG = 10 * MiB;
constexpr size_t WS_WU = 26 * MiB;
constexpr size_t WS_WD = 42 * MiB;
constexpr size_t WS_AGG = 58 * MiB;
constexpr size_t WS_GATES = 60 * MiB;
constexpr size_t WS_LIST = 61 * MiB;
constexpr size_t WS_XN = 64 * MiB;
constexpr size_t WS_XL = 128 * MiB;
constexpr size_t WS_GL = 160 * MiB;
constexpr size_t WS_Q = 192 * MiB;
constexpr size_t WS_K = 224 * MiB;
constexpr size_t WS_V = 256 * MiB;
constexpr size_t WS_Y = 288 * MiB;
constexpr size_t WS_HID = 128 * MiB;
constexpr int HID_ROWS = T + NBK * 256;
constexpr size_t WS_END = 352 * MiB;
static_assert(WS_HID + (size_t)HID_ROWS * 2048 <= WS_K, "hid overlay");
constexpr int CW_TMO = 0, CW_BAR = 4096, CW_CNT = 8192;

constexpr int SCR_BYTES = 143360;
constexpr int LDSCTL_OFF = SCR_BYTES, MISC_OFF = LDSCTL_OFF + 320;
constexpr int LDS_BYTES = 147456;

__device__ __forceinline__ unsigned f2bf(float f) { unsigned u = __builtin_bit_cast(unsigned, f); return (u + 0x7fffu + ((u >> 16) & 1u)) >> 16; }
__device__ __forceinline__ unsigned pk2(float lo, float hi) { return f2bf(lo) | (f2bf(hi) << 16); }
__device__ __forceinline__ float bf2f(bf16 b) { return __builtin_bit_cast(float, (unsigned)b << 16); }
__device__ __forceinline__ float bflo(unsigned w) { return __builtin_bit_cast(float, w << 16); }
__device__ __forceinline__ float bfhi(unsigned w) { return __builtin_bit_cast(float, w & 0xffff0000u); }
__device__ __forceinline__ float wave_sum(float v) {
#pragma unroll
    for (int o = 1; o < 64; o <<= 1) v += __shfl_xor(v, o);
    return v;
}
__device__ __forceinline__ float sigmoidf_(float x) { return 1.0f / (1.0f + __expf(-x)); }
__device__ __forceinline__ float gelu_tanh(float x) {
    const float z = 0.7978845608028654f * (x + 0.044715f * x * x * x);
    const float e = __expf(2.0f * z);
    const float th = 1.0f - 2.0f / (e + 1.0f);
    return 0.5f * x * (1.0f + th);
}

#define XB_TMO      128
#define XB_XCNT(j)  (256  + 64 * (j))
#define XB_XSUB(j)  (1280 + 64 * (j))
#define XB_XGEN(j)  (2304 + 64 * (j))
#define XB_TOP      3328
#define XB_TOPGEN   3392
#define XCD_BAR_WORDS 3456
#define XB_SPIN_CAP (1u << 18)
__device__ __forceinline__ unsigned xb_ld(unsigned* p)              { return __hip_atomic_load(p, __ATOMIC_RELAXED, __HIP_MEMORY_SCOPE_AGENT); }
__device__ __forceinline__ unsigned xb_add(unsigned* p, unsigned v) { return __hip_atomic_fetch_add(p, v, __ATOMIC_RELAXED, __HIP_MEMORY_SCOPE_AGENT); }
__device__ __forceinline__ unsigned xb_xcc_id() { return (unsigned)__builtin_amdgcn_s_getreg((3 << 11) | 20) & 0xFu; }
#define XB_SPIN(cond, bar) do { unsigned _sp = 0; while (cond) { __builtin_amdgcn_s_sleep(1); \
    if ((++_sp & 255u) == 0u) { if (xb_ld(&(bar)[XB_TMO])) break; if (_sp > XB_SPIN_CAP) { atomicAdd(&(bar)[XB_TMO], 1u); break; } } } } while (0)
struct XcdBarrier { unsigned* bar; unsigned x; volatile LAS unsigned* st; };
__device__ __forceinline__ XcdBarrier xcd_barrier_post(unsigned* bar, volatile LAS unsigned* st) {
    XcdBarrier b; b.bar = bar; b.x = xb_xcc_id(); b.st = st;
    if (threadIdx.x == 0) (void)xb_add(&bar[XB_XCNT(b.x)], 1u);
    return b;
}
__device__ __forceinline__ void xcd_barrier_complete(unsigned* bar, unsigned x, unsigned& nloc, unsigned& nx) {
    const unsigned G = gridDim.x * gridDim.y * gridDim.z;
    unsigned sum, cnt, mine, sp = 0u;
    for (;;) {
        sum = 0u; cnt = 0u; mine = 0u;
#pragma unroll
        for (unsigned j = 0; j < 16; ++j) { const unsigned c = xb_ld(&bar[XB_XCNT(j)]); sum += c; cnt += (c > 0u) ? 1u : 0u; mine = (j == x) ? c : mine; }
        if (sum == G) break;
        __builtin_amdgcn_s_sleep(1);
        if ((++sp & 255u) == 0u) { if (xb_ld(&bar[XB_TMO])) break; if (sp > XB_SPIN_CAP) { atomicAdd(&bar[XB_TMO], 1u); break; } }
    }
    nloc = mine > 0u ? mine : 1u; nx = cnt > 0u ? cnt : 1u;
}
__device__ __forceinline__ void xcd_barrier(const XcdBarrier& b) {
    asm volatile("s_waitcnt vmcnt(0)" ::: "memory");
    __syncthreads();
    if (threadIdx.x == 0) {
        unsigned* bar = b.bar;
        __builtin_amdgcn_s_waitcnt(0);
        unsigned nloc = b.st[0], nx = b.st[1];
        if (nloc == 0u) { xcd_barrier_complete(bar, b.x, nloc, nx); b.st[0] = nloc; b.st[1] = nx; }
        const unsigned old = xb_add(&bar[XB_XSUB(b.x)], 1u);
        const unsigned gen = old / nloc;
        if (old + 1u == (gen + 1u) * nloc) {
            __builtin_amdgcn_fence(__ATOMIC_RELEASE, "agent");
            asm volatile("s_waitcnt vmcnt(0)" ::: "memory");
            const unsigned og = xb_add(&bar[XB_TOP], 1u);
            const unsigned tg = og / nx;
            if (og + 1u == (tg + 1u) * nx) xb_add(&bar[XB_TOPGEN], 1u);
            else XB_SPIN(xb_ld(&bar[XB_TOPGEN]) == tg, bar);
            __builtin_amdgcn_fence(__ATOMIC_ACQUIRE, "agent");
            xb_add(&bar[XB_XGEN(b.x)], 1u);
            asm volatile("s_waitcnt vmcnt(0)" ::: "memory");
        } else {
            XB_SPIN(xb_ld(&bar[XB_XGEN(b.x)]) == gen, bar);
            __builtin_amdgcn_fence(__ATOMIC_ACQUIRE, "agent");
            asm volatile("s_waitcnt vmcnt(0)" ::: "memory");
        }
    }
    __syncthreads();
}

struct Args { const float* in[27]; float* out; unsigned char* ws; int ph_lo, ph_hi, li, pad; };
struct Frame {
    LAS unsigned char* lds; volatile LAS unsigned* MISC; gu32* ctl;
    int tid, lane, wave, vcu, G;
    unsigned char* ws; float* out;
};

__device__ __forceinline__ void p0_transpose_item(const float* W, int K, int N, bf16* WT, LAS float* scr, int item, int lane) {
    const int nblk = N / 32, kb = item / nblk, nb = item % nblk, k0 = 64 * kb, n0 = 32 * nb;
#pragma unroll 8
    for (int i = 0; i < 32; ++i) { const int kk = 2 * i + (lane >> 5); scr[kk * 33 + (lane & 31)] = W[(size_t)(k0 + kk) * N + n0 + (lane & 31)]; }
    LDS_WAIT(); asm volatile("" ::: "memory");
    const int c = lane & 7;
#pragma unroll
    for (int j = 0; j < 4; ++j) { const int n = (lane >> 3) + 8 * j; const LAS float* s = scr + (8 * c) * 33 + n;
        v4u o; o.x = pk2(s[0 * 33], s[1 * 33]); o.y = pk2(s[2 * 33], s[3 * 33]); o.z = pk2(s[4 * 33], s[5 * 33]); o.w = pk2(s[6 * 33], s[7 * 33]);
        *(GAS v4u*)(WT + (size_t)(n0 + n) * K + k0 + 8 * c) = o; }
    LDS_WAIT(); asm volatile("" ::: "memory");
}
__device__ __forceinline__ void rms_row_to_bf16(const float* xrow, const float* g, bf16* orow, int lane) {
    const GAS f32x4* xr = (const GAS f32x4*)xrow + lane;
    const GAS f32x4* gr = (const GAS f32x4*)g + lane;
    f32x4 v[4]; float s = 0.f;
#pragma unroll
    for (int j = 0; j < 4; ++j) { v[j] = xr[64 * j]; s += (v[j].x * v[j].x + v[j].y * v[j].y) + (v[j].z * v[j].z + v[j].w * v[j].w); }
    const float r = 1.0f / sqrtf(wave_sum(s) * (1.0f / DM) + EPS);
    GAS v2u* o8 = (GAS v2u*)orow + lane;
#pragma unroll
    for (int j = 0; j < 4; ++j) { const f32x4 gg = gr[64 * j]; v2u w; w.x = pk2(v[j].x * r * gg.x, v[j].y * r * gg.y); w.y = pk2(v[j].z * r * gg.z, v[j].w * r * gg.w); o8[64 * j] = w; }
}
__device__ __forceinline__ void p0_prologue(Frame& F, const Args& a) {
    LAS float* scr = (LAS float*)(F.lds + F.wave * 16384);
    const int gw = F.vcu * NWAVES + F.wave, NGW = F.G * NWAVES;
    constexpr int I_IN = (DM / 64) * (INC / 32), I_OUT = (DM / 64) * (DM / 32), I_E = 256;
    constexpr int NITEMS = I_IN + I_OUT + 3 * NE * I_E;
    bf16* Win_t = (bf16*)(F.ws + WS_WIN); bf16* Wout_t = (bf16*)(F.ws + WS_WOUT);
    bf16* Wg_t = (bf16*)(F.ws + WS_WG); bf16* Wu_t = (bf16*)(F.ws + WS_WU); bf16* Wd_t = (bf16*)(F.ws + WS_WD);
    for (int it = gw; it < NITEMS; it += NGW) {
        int r = it;
        if (r < I_IN) { p0_transpose_item(a.in[2], DM, INC, Win_t, scr, r, F.lane); continue; } r -= I_IN;
        if (r < I_OUT) { p0_transpose_item(a.in[18], DM, DM, Wout_t, scr, r, F.lane); continue; } r -= I_OUT;
        if (r < NE * I_E) { const int e = r / I_E; p0_transpose_item(a.in[24] + (size_t)e * DM * DE, DM, DE, Wg_t + (size_t)e * DE * DM, scr, r % I_E, F.lane); continue; } r -= NE * I_E;
        if (r < NE * I_E) { const int e = r / I_E; p0_transpose_item(a.in[25] + (size_t)e * DM * DE, DM, DE, Wu_t + (size_t)e * DE * DM, scr, r % I_E, F.lane); continue; } r -= NE * I_E;
        { const int e = r / I_E; p0_transpose_item(a.in[26] + (size_t)e * DE * DM, DE, DM, Wd_t + (size_t)e * DM * DE, scr, r % I_E, F.lane); }
    }
    bf16* XN = (bf16*)(F.ws + WS_XN);
    for (int m = gw; m < T; m += NGW) rms_row_to_bf16(a.in[0] + (size_t)m * DM, a.in[1], XN + (size_t)m * DM, F.lane);
}

template <class AF, class BF>
__device__ __forceinline__ void ngemm_acc(LAS float* As, LAS float* Bs, int K, AF arow, BF bcol, float (&acc)[8]) {
    const int tid = threadIdx.x, r = tid >> 3, cg = tid & 7;
    const bf16* ap = arow(r); const bf16* bp = bcol(r);
    for (int k0 = 0; k0 < K; k0 += 64) {
        __syncthreads();
        const v4u va = *(const GAS v4u*)(ap + k0 + cg * 8);
        const v4u vb = *(const GAS v4u*)(bp + k0 + cg * 8);
#pragma unroll
        for (int j = 0; j < 4; ++j) {
            As[r * 65 + cg * 8 + 2 * j] = bflo(va[j]); As[r * 65 + cg * 8 + 2 * j + 1] = bfhi(va[j]);
            Bs[(cg * 8 + 2 * j) * 72 + r] = bflo(vb[j]); Bs[(cg * 8 + 2 * j + 1) * 72 + r] = bfhi(vb[j]);
        }
        __syncthreads();
#pragma unroll 8
        for (int kk = 0; kk < 64; ++kk) {
            const float av = As[r * 65 + kk];
            const f32x4 b0 = *(const LAS f32x4*)&Bs[kk * 72 + cg * 8], b1 = *(const LAS f32x4*)&Bs[kk * 72 + cg * 8 + 4];
            acc[0] += av * b0.x; acc[1] += av * b0.y; acc[2] += av * b0.z; acc[3] += av * b0.w;
            acc[4] += av * b1.x; acc[5] += av * b1.y; acc[6] += av * b1.z; acc[7] += av * b1.w;
        }
    }
}
__device__ __forceinline__ v4u pack8(const float (&v)[8]) { v4u o; o.x = pk2(v[0], v[1]); o.y = pk2(v[2], v[3]); o.z = pk2(v[4], v[5]); o.w = pk2(v[6], v[7]); return o; }
__device__ __forceinline__ float sum8lanes(float v) { v += __shfl_xor(v, 1); v += __shfl_xor(v, 2); v += __shfl_xor(v, 4); return v; }
__device__ __forceinline__ float max8lanes(float v) { v = fmaxf(v, __shfl_xor(v, 1)); v = fmaxf(v, __shfl_xor(v, 2)); v = fmaxf(v, __shfl_xor(v, 4)); return v; }

__device__ __forceinline__ void p1_simple(Frame& F, const Args& a) {
    LAS float* As = (LAS float*)F.lds; LAS float* Bs = As + 64 * 65;
    const bf16* XN = (const bf16*)(F.ws + WS_XN); const bf16* Win_t = (const bf16*)(F.ws + WS_WIN);
    const int tid = F.tid, r = tid >> 3, cg = tid & 7;
    constexpr int NCT = INC / 64;
    for (int tt = F.vcu; tt < (T / 64) * NCT; tt += F.G) {
        const int rt = tt / NCT, ct = tt % NCT;
        float acc[8] = {0.f, 0.f, 0.f, 0.f, 0.f, 0.f, 0.f, 0.f};
        ngemm_acc(As, Bs, DM, [&](int rr) { return XN + (size_t)(rt * 64 + rr) * DM; }, [&](int cc) { return Win_t + (size_t)(ct * 64 + cc) * DM; }, acc);
        const int region = ct >> 3, lc0 = (ct & 7) * 64 + cg * 8; const size_t row = (size_t)rt * 64 + r;
        bf16* dst = (bf16*)(F.ws + WS_XL + (size_t)region * 32 * MiB) + row * 512 + lc0;
        if (region == 1) {
#pragma unroll
            for (int j = 0; j < 8; ++j) acc[j] = gelu_tanh(acc[j]);
        } else if (region == 2 || region == 3) {
            float ss = 0.f;
#pragma unroll
            for (int j = 0; j < 8; ++j) ss += acc[j] * acc[j];
            ss = sum8lanes(ss);
            const float rr = (1.0f / sqrtf(ss * (1.0f / HD) + EPS)) * (region == 2 ? C2 : 1.0f);
            const float* g = a.in[region == 2 ? 11 : 12] + cg * 8;
#pragma unroll
            for (int j = 0; j < 8; ++j) acc[j] = acc[j] * rr * g[j];
        }
        *(GAS v4u*)dst = pack8(acc);
    }
}

template <bool APPLY>
__device__ __forceinline__ void lru_chunk(Frame& F, const Args& a, int b, int j) {
    LAS float* XC = (LAS float*)F.lds;
    const int ch = F.tid; const size_t row0 = (size_t)b * SEQ + (size_t)j * 64;
    const bf16* XL = (const bf16*)(F.ws + WS_XL); const bf16* GL = (const bf16*)(F.ws + WS_GL);
    float* AGG = (float*)(F.ws + WS_AGG);
    __syncthreads();
    {
        const float cw0 = a.in[3][ch], cw1 = a.in[3][512 + ch], cw2 = a.in[3][1024 + ch], cw3 = a.in[3][1536 + ch], cb = a.in[4][ch];
        float x0 = 0.f, x1 = 0.f, x2 = 0.f;
        if (j > 0) { x0 = bf2f(XL[(row0 - 3) * 512 + ch]); x1 = bf2f(XL[(row0 - 2) * 512 + ch]); x2 = bf2f(XL[(row0 - 1) * 512 + ch]); }
#pragma unroll 8
        for (int t = 0; t < 64; ++t) {
            const float x3 = bf2f(XL[(row0 + t) * 512 + ch]);
            XC[t * 512 + ch] = cb + cw0 * x0 + cw1 * x1 + cw2 * x2 + cw3 * x3;
            x0 = x1; x1 = x2; x2 = x3;
        }
    }
    __syncthreads();
    float ra[64], ri[64];
#pragma unroll
    for (int t = 0; t < 64; ++t) { ra[t] = 0.f; ri[t] = 0.f; }
    {
        const int blk = ch >> 6, d = ch & 63;
        const float* Wa = a.in[5] + blk * 4096 + d; const float* Wx = a.in[7] + blk * 4096 + d;
        const LAS float* xb = XC + blk * 64;
#pragma unroll 1
        for (int c = 0; c < 64; c += 4) {
            const float wa0 = Wa[(c + 0) * 64], wa1 = Wa[(c + 1) * 64], wa2 = Wa[(c + 2) * 64], wa3 = Wa[(c + 3) * 64];
            const float wx0 = Wx[(c + 0) * 64], wx1 = Wx[(c + 1) * 64], wx2 = Wx[(c + 2) * 64], wx3 = Wx[(c + 3) * 64];
#pragma unroll
            for (int t = 0; t < 64; ++t) {
                const f32x4 xv = *(const LAS f32x4*)&xb[t * 512 + c];
                ra[t] += xv.x * wa0 + xv.y * wa1 + xv.z * wa2 + xv.w * wa3;
                ri[t] += xv.x * wx0 + xv.y * wx1 + xv.z * wx2 + xv.w * wx3;
            }
        }
    }
    __syncthreads();
    const float sp = log1pf(expf(-a.in[9][ch]));
    const float ba = a.in[6][ch], bx = a.in[8][ch];
    float h = 0.f, lasum = 0.f;
    if (APPLY) {
        for (int i = 0; i < j; ++i) { const float A = AGG[((size_t)(b * 32 + i) * 2 + 0) * 512 + ch], H = AGG[((size_t)(b * 32 + i) * 2 + 1) * 512 + ch]; h = A * h + H; }
    }
#pragma unroll
    for (int t = 0; t < 64; ++t) {
        const float xc = XC[t * 512 + ch];
        const float rg = sigmoidf_(ra[t] + ba), ig = sigmoidf_(ri[t] + bx);
        const float la = -8.0f * rg * sp;
        const float av = expf(la);
        const float u = sqrtf(-expm1f(2.0f * la)) * (ig * xc);
        h = av * h + u;
        if (APPLY) XC[t * 512 + ch] = h * bf2f(GL[(row0 + t) * 512 + ch]);
        else lasum += la;
    }
    if (!APPLY) {
        AGG[((size_t)(b * 32 + j) * 2 + 0) * 512 + ch] = expf(lasum);
        AGG[((size_t)(b * 32 + j) * 2 + 1) * 512 + ch] = h;
        return;
    }
    __syncthreads();
    bf16* Y = (bf16*)(F.ws + WS_Y);
    const f32x4 g0 = *(const GAS f32x4*)(a.in[10] + F.lane * 8), g1 = *(const GAS f32x4*)(a.in[10] + F.lane * 8 + 4);
#pragma unroll
    for (int i = 0; i < 8; ++i) {
        const int t = F.wave + 8 * i;
        const f32x4 y0 = *(const LAS f32x4*)&XC[t * 512 + F.lane * 8], y1 = *(const LAS f32x4*)&XC[t * 512 + F.lane * 8 + 4];
        float ss = (y0.x * y0.x + y0.y * y0.y) + (y0.z * y0.z + y0.w * y0.w) + (y1.x * y1.x + y1.y * y1.y) + (y1.z * y1.z + y1.w * y1.w);
        const float r = 1.0f / sqrtf(wave_sum(ss) * (1.0f / LW) + EPS);
        v4u o; o.x = pk2(y0.x * r * g0.x, y0.y * r * g0.y); o.y = pk2(y0.z * r * g0.z, y0.w * r * g0.w); o.z = pk2(y1.x * r * g1.x, y1.y * r * g1.y); o.w = pk2(y1.z * r * g1.z, y1.w * r * g1.w);
        *(GAS v4u*)(Y + (row0 + t) * DM + F.lane * 8) = o;
    }
}

__device__ __forceinline__ void nattn_unit(Frame& F, const Args& a, int b, int h, int c, float lam) {
    LAS float* Qs = (LAS float*)F.lds; LAS float* Ks = Qs + 64 * 132; LAS float* Vs = Ks + 64 * 132; LAS float* Ps = Vs + 64 * 132;
    const bf16* Qg = (const bf16*)(F.ws + WS_Q); const bf16* Kg = (const bf16*)(F.ws + WS_K); const bf16* Vg = (const bf16*)(F.ws + WS_V);
    const int tid = F.tid, qi = tid >> 3, sub = tid & 7;
    const float slope2 = exp2f(-2.0f * (float)(h + 1)) * LOG2E;
    __syncthreads();
    {
        const bf16* src = Qg + ((size_t)b * SEQ + 64 * c + qi) * 512 + h * 128 + sub * 16;
        const v4u v0 = *(const GAS v4u*)src, v1 = *(const GAS v4u*)(src + 8);
        LAS float* d = Qs + qi * 132 + sub * 16;
#pragma unroll
        for (int i = 0; i < 4; ++i) { d[2 * i] = bflo(v0[i]); d[2 * i + 1] = bfhi(v0[i]); d[8 + 2 * i] = bflo(v1[i]); d[8 + 2 * i + 1] = bfhi(v1[i]); }
    }
    float m0 = -1e30f, m1 = -1e30f, l0 = 0.f, l1 = 0.f, O0[16], O1[16];
#pragma unroll
    for (int i = 0; i < 16; ++i) { O0[i] = 0.f; O1[i] = 0.f; }
    for (int kt = 0; kt <= c; ++kt) {
        __syncthreads();
        {
            const size_t off = ((size_t)b * SEQ + 64 * kt + qi) * 512 + h * 128 + sub * 16;
            const v4u k0 = *(const GAS v4u*)(Kg + off), k1 = *(const GAS v4u*)(Kg + off + 8);
            const v4u v0 = *(const GAS v4u*)(Vg + off), v1 = *(const GAS v4u*)(Vg + off + 8);
            LAS float* dk = Ks + qi * 132 + sub * 16; LAS float* dv = Vs + qi * 132 + sub * 16;
#pragma unroll
            for (int i = 0; i < 4; ++i) {
                dk[2 * i] = bflo(k0[i]); dk[2 * i + 1] = bfhi(k0[i]); dk[8 + 2 * i] = bflo(k1[i]); dk[8 + 2 * i + 1] = bfhi(k1[i]);
                dv[2 * i] = bflo(v0[i]); dv[2 * i + 1] = bfhi(v0[i]); dv[8 + 2 * i] = bflo(v1[i]); dv[8 + 2 * i + 1] = bfhi(v1[i]);
            }
        }
        __syncthreads();
        float e0[8], e1[8];
#pragma unroll
        for (int j = 0; j < 8; ++j) {
            const int kk = sub + 8 * j;
            float s0 = 0.f, s1 = 0.f;
#pragma unroll
            for (int d = 0; d < 64; d += 4) {
                const f32x4 q0 = *(const LAS f32x4*)&Qs[qi * 132 + d], k0 = *(const LAS f32x4*)&Ks[kk * 132 + d];
                const f32x4 q1 = *(const LAS f32x4*)&Qs[qi * 132 + 64 + d], k1 = *(const LAS f32x4*)&Ks[kk * 132 + 64 + d];
                s0 += (q0.x * k0.x + q0.y * k0.y) + (q0.z * k0.z + q0.w * k0.w);
                s1 += (q1.x * k1.x + q1.y * k1.y) + (q1.z * k1.z + q1.w * k1.w);
            }
            const int dist = (64 * c + qi) - (64 * kt + kk);
            const float bias = -slope2 * (float)(dist < 0 ? -dist : dist);
            e0[j] = s0 + bias; e1[j] = s1 + bias;
        }
        {
            float tm = e0[0];
#pragma unroll
            for (int j = 1; j < 8; ++j) tm = fmaxf(tm, e0[j]);
            tm = max8lanes(tm);
            const float mn = fmaxf(m0, tm), al = exp2f(m0 - mn);
            float ps = 0.f;
#pragma unroll
            for (int j = 0; j < 8; ++j) { const float p = exp2f(e0[j] - mn); ps += p; Ps[qi * 65 + sub + 8 * j] = p; }
            ps = sum8lanes(ps);
            l0 = l0 * al + ps; m0 = mn;
#pragma unroll
            for (int i = 0; i < 16; ++i) O0[i] *= al;
        }
        {
            float tm = e1[0];
#pragma unroll
            for (int j = 1; j < 8; ++j) tm = fmaxf(tm, e1[j]);
            tm = max8lanes(tm);
            const float mn = fmaxf(m1, tm), al = exp2f(m1 - mn);
            float ps = 0.f;
#pragma unroll
            for (int j = 0; j < 8; ++j) { const float p = exp2f(e1[j] - mn); ps += p; Ps[(64 + qi) * 65 + sub + 8 * j] = p; }
            ps = sum8lanes(ps);
            l1 = l1 * al + ps; m1 = mn;
#pragma unroll
            for (int i = 0; i < 16; ++i) O1[i] *= al;
        }
        __syncthreads();
#pragma unroll 4
        for (int kk = 0; kk < 64; ++kk) {
            const float p0 = Ps[qi * 65 + kk], p1 = Ps[(64 + qi) * 65 + kk];
            const LAS f32x4* vp = (const LAS f32x4*)&Vs[kk * 132 + sub * 16];
#pragma unroll
            for (int q = 0; q < 4; ++q) { const f32x4 v = vp[q];
                O0[4 * q] += p0 * v.x; O0[4 * q + 1] += p0 * v.y; O0[4 * q + 2] += p0 * v.z; O0[4 * q + 3] += p0 * v.w;
                O1[4 * q] += p1 * v.x; O1[4 * q + 1] += p1 * v.y; O1[4 * q + 2] += p1 * v.z; O1[4 * q + 3] += p1 * v.w; }
        }
    }
    const float il0 = 1.0f / l0, il1 = lam / l1;
    float o[16], ss = 0.f;
#pragma unroll
    for (int i = 0; i < 16; ++i) { o[i] = O0[i] * il0 - O1[i] * il1; ss += o[i] * o[i]; }
    ss = sum8lanes(ss);
    const float r = (1.0f / sqrtf(ss * (1.0f / VD) + EPS)) * 0.8f;
    const float* sg = a.in[17] + sub * 16;
    float o8a[8], o8b[8];
#pragma unroll
    for (int i = 0; i < 8; ++i) { o8a[i] = o[i] * r * sg[i]; o8b[i] = o[8 + i] * r * sg[8 + i]; }
    bf16* dst = (bf16*)(F.ws + WS_Y) + ((size_t)b * SEQ + 64 * c + qi) * DM + 512 + h * 128 + sub * 16;
    *(GAS v4u*)dst = pack8(o8a); *(GAS v4u*)(dst + 8) = pack8(o8b);
}
__device__ __forceinline__ float diff_lambda(const Args& a) {
    float s1 = 0.f, s2 = 0.f;
    for (int i = 0; i < HD; ++i) { s1 += a.in[13][i] * a.in[14][i]; s2 += a.in[15][i] * a.in[16][i]; }
    return expf(s1) - expf(s2) + 0.2f;
}
__device__ __forceinline__ void p3_simple(Frame& F, const Args& a) {
    const float lam = diff_lambda(a);
    for (int i = F.vcu; i < BATCH * NH * 32; i += F.G) { const int c = 31 - (i >> 6), bh = i & 63; nattn_unit(F, a, bh >> 2, bh & 3, c, lam); }
    for (int i = F.vcu; i < BATCH * 32; i += F.G) lru_chunk<true>(F, a, i >> 5, i & 31);
}

__device__ __forceinline__ void p4_simple(Frame& F, const Args& a) {
    LAS float* As = (LAS float*)F.lds; LAS float* Bs = As + 64 * 65;
    const bf16* Y = (const bf16*)(F.ws + WS_Y); const bf16* Wout_t = (const bf16*)(F.ws + WS_WOUT);
    const int tid = F.tid, r = tid >> 3, cg = tid & 7;
    for (int tt = F.vcu; tt < (T / 64) * 16; tt += F.G) {
        const int rt = tt >> 4, ct = tt & 15;
        float acc[8] = {0.f, 0.f, 0.f, 0.f, 0.f, 0.f, 0.f, 0.f};
        ngemm_acc(As, Bs, DM, [&](int rr) { return Y + (size_t)(rt * 64 + rr) * DM; }, [&](int cc) { return Wout_t + (size_t)(ct * 64 + cc) * DM; }, acc);
        const size_t off = ((size_t)rt * 64 + r) * DM + ct * 64 + cg * 8;
        const f32x4 x0 = *(const GAS f32x4*)(a.in[0] + off), x1 = *(const GAS f32x4*)(a.in[0] + off + 4);
        *(GAS f32x4*)(F.out + off) = (f32x4){x0.x + acc[0], x0.y + acc[1], x0.z + acc[2], x0.w + acc[3]};
        *(GAS f32x4*)(F.out + off + 4) = (f32x4){x1.x + acc[4], x1.y + acc[5], x1.z + acc[6], x1.w + acc[7]};
    }
}

__device__ __forceinline__ void p5_route(Frame& F, const Args& a) {
    LAS float* Wr = (LAS float*)F.lds;
    __syncthreads();
    for (int i = F.tid; i < 20 * 1024; i += NTHR) {
        const int c = i >> 10, k = i & 1023;
        Wr[i] = (c < 4) ? a.in[20][k * 4 + c] : a.in[22][((size_t)((c - 4) >> 2) * 1024 + k) * 4 + ((c - 4) & 3)];
    }
    __syncthreads();
    const int gw = F.vcu * NWAVES + F.wave, NGW = F.G * NWAVES, lane = F.lane;
    bf16* HN2 = (bf16*)(F.ws + WS_XN); float* gates = (float*)(F.ws + WS_GATES); int* list = (int*)(F.ws + WS_LIST);
    const GAS f32x4* gr = (const GAS f32x4*)a.in[19] + lane;
    for (int m = gw; m < T; m += NGW) {
        const GAS f32x4* xr = (const GAS f32x4*)(F.out + (size_t)m * DM) + lane;
        f32x4 v[4]; float s = 0.f;
#pragma unroll
        for (int j = 0; j < 4; ++j) { v[j] = xr[64 * j]; s += (v[j].x * v[j].x + v[j].y * v[j].y) + (v[j].z * v[j].z + v[j].w * v[j].w); }
        const float r = 1.0f / sqrtf(wave_sum(s) * (1.0f / DM) + EPS);
        GAS v2u* o8 = (GAS v2u*)(HN2 + (size_t)m * DM) + lane;
#pragma unroll
        for (int j = 0; j < 4; ++j) { const f32x4 gg = gr[64 * j]; v[j].x *= r * gg.x; v[j].y *= r * gg.y; v[j].z *= r * gg.z; v[j].w *= r * gg.w;
            v2u w; w.x = pk2(v[j].x, v[j].y); w.y = pk2(v[j].z, v[j].w); o8[64 * j] = w; }
        float lg[20];
#pragma unroll
        for (int c = 0; c < 20; ++c) {
            float acc = 0.f;
#pragma unroll
            for (int j = 0; j < 4; ++j) { const f32x4 w = *(const LAS f32x4*)&Wr[c * 1024 + 256 * j + 4 * lane]; acc += (v[j].x * w.x + v[j].y * w.y) + (v[j].z * w.z + v[j].w * w.w); }
            lg[c] = wave_sum(acc);
            asm volatile("" ::: "memory");
        }
        float gl0 = lg[0] + a.in[21][0], gl1 = lg[1] + a.in[21][1], gl2 = lg[2] + a.in[21][2], gl3 = lg[3] + a.in[21][3];
        int gi = 0; float gm = gl0;
        if (gl1 > gm) { gm = gl1; gi = 1; } if (gl2 > gm) { gm = gl2; gi = 2; } if (gl3 > gm) { gm = gl3; gi = 3; }
        const float pg = 1.0f / (expf(gl0 - gm) + expf(gl1 - gm) + expf(gl2 - gm) + expf(gl3 - gm));
        float el[4];
#pragma unroll
        for (int e = 0; e < 4; ++e) { const float sel = gi == 0 ? lg[4 + e] : gi == 1 ? lg[8 + e] : gi == 2 ? lg[12 + e] : lg[16 + e]; el[e] = sel + a.in[23][gi * 4 + e]; }
        int e1 = 0; float v1 = el[0];
#pragma unroll
        for (int e = 1; e < 4; ++e) if (el[e] > v1) { v1 = el[e]; e1 = e; }
        int e2 = -1; float v2 = -3.0e38f;
#pragma unroll
        for (int e = 0; e < 4; ++e) if (e != e1 && el[e] > v2) { v2 = el[e]; e2 = e; }
        const float w1 = 1.0f / (1.0f + expf(v2 - v1)), w2 = 1.0f - w1;
        const int lo = e1 < e2 ? e1 : e2, hi = e1 < e2 ? e2 : e1;
        const float glo = pg * (e1 < e2 ? w1 : w2), ghi = pg * (e1 < e2 ? w2 : w1);
        const int pi = lo == 0 ? hi - 1 : (lo == 1 ? hi + 1 : 5);
        const int bk = gi * 6 + pi;
        if (lane == 0) {
            const unsigned slot = __hip_atomic_fetch_add((unsigned*)(F.ctl + CW_CNT + bk), 1u, RLX_AGENT);
            list[(size_t)bk * T + slot] = m; gates[2 * (size_t)m] = glo; gates[2 * (size_t)m + 1] = ghi;
        }
    }
}

__device__ __forceinline__ void bucket_tables(Frame& F, LAS int* tb) {
    __syncthreads();
    if (F.tid == 0) {
        int off = 0, pre = 0;
        for (int k = 0; k < NBK; ++k) {
            const int c = (int)__hip_atomic_load((unsigned*)(F.ctl + CW_CNT + k), RLX_AGENT);
            tb[k] = c; tb[24 + k] = off; tb[49 + k] = pre; off += (c + 255) & ~255; pre += (c + 63) >> 6;
        }
        tb[24 + 24] = off; tb[49 + 24] = pre;
    }
    __syncthreads();
}
__device__ __forceinline__ void bk_experts(int bk, int& elo, int& ehi) {
    const int g = bk / 6, pi = bk % 6;
    const int lo = pi < 3 ? 0 : (pi < 5 ? 1 : 2), hi = pi < 3 ? pi + 1 : (pi < 5 ? pi - 1 : 3);
    elo = g * 4 + lo; ehi = g * 4 + hi;
}

__device__ __forceinline__ void p6_simple(Frame& F, const Args& a) {
    LAS float* As = (LAS float*)F.lds; LAS float* Bs = As + 64 * 65; LAS int* tb = (LAS int*)(Bs + 64 * 72);
    bucket_tables(F, tb);
    const bf16* HN2 = (const bf16*)(F.ws + WS_XN); const bf16* Wg_t = (const bf16*)(F.ws + WS_WG); const bf16* Wu_t = (const bf16*)(F.ws + WS_WU);
    const float* gates = (const float*)(F.ws + WS_GATES); const int* list = (const int*)(F.ws + WS_LIST);
    bf16* HID = (bf16*)(F.ws + WS_HID);
    const int tid = F.tid, r = tid >> 3, cg = tid & 7;
    const int ntile = tb[49 + 24];
    for (int u = F.vcu; u < ntile * 16; u += F.G) {
        const int tile = u >> 4, x = (u >> 3) & 1, jt = u & 7;
        int bk = 0;
        for (int k = 1; k < NBK; ++k) if (tile >= tb[49 + k]) bk = k;
        const int rt = tile - tb[49 + bk], cnt = tb[bk], off = tb[24 + bk];
        int elo, ehi; bk_experts(bk, elo, ehi); const int e = x ? ehi : elo;
        const int idx = rt * 64 + r; const bool valid = idx < cnt;
        const int tok = list[(size_t)bk * T + (valid ? idx : 0)];
        const float gate = valid ? gates[2 * (size_t)tok + x] : 0.f;
        float ag[8] = {0.f, 0.f, 0.f, 0.f, 0.f, 0.f, 0.f, 0.f}, au[8] = {0.f, 0.f, 0.f, 0.f, 0.f, 0.f, 0.f, 0.f};
        ngemm_acc(As, Bs, DM, [&](int) { return HN2 + (size_t)tok * DM; }, [&](int cc) { return Wg_t + ((size_t)e * DE + jt * 64 + cc) * DM; }, ag);
        ngemm_acc(As, Bs, DM, [&](int) { return HN2 + (size_t)tok * DM; }, [&](int cc) { return Wu_t + ((size_t)e * DE + jt * 64 + cc) * DM; }, au);
        float hv[8];
#pragma unroll
        for (int j = 0; j < 8; ++j) hv[j] = ag[j] * sigmoidf_(ag[j]) * au[j] * gate;
        *(GAS v4u*)(HID + (size_t)(off + idx) * DM + x * 512 + jt * 64 + cg * 8) = pack8(hv);
    }
}
__device__ __forceinline__ void p7_simple(Frame& F, const Args& a) {
    LAS float* As = (LAS float*)F.lds; LAS float* Bs = As + 64 * 65; LAS int* tb = (LAS int*)(Bs + 64 * 72);
    bucket_tables(F, tb);
    const bf16* HID = (const bf16*)(F.ws + WS_HID); const bf16* Wd_t = (const bf16*)(F.ws + WS_WD);
    const int* list = (const int*)(F.ws + WS_LIST);
    const int tid = F.tid, r = tid >> 3, cg = tid & 7;
    const int ntile = tb[49 + 24];
    for (int u = F.vcu; u < ntile * 16; u += F.G) {
        const int tile = u >> 4, ct = u & 15;
        int bk = 0;
        for (int k = 1; k < NBK; ++k) if (tile >= tb[49 + k]) bk = k;
        const int rt = tile - tb[49 + bk], cnt = tb[bk], off = tb[24 + bk];
        int elo, ehi; bk_experts(bk, elo, ehi);
        const int idx = rt * 64 + r; const bool valid = idx < cnt;
        float acc[8] = {0.f, 0.f, 0.f, 0.f, 0.f, 0.f, 0.f, 0.f};
        ngemm_acc(As, Bs, DE, [&](int rr) { return HID + (size_t)(off + rt * 64 + rr) * DM; }, [&](int cc) { return Wd_t + ((size_t)elo * DM + ct * 64 + cc) * DE; }, acc);
        ngemm_acc(As, Bs, DE, [&](int rr) { return HID + (size_t)(off + rt * 64 + rr) * DM + 512; }, [&](int cc) { return Wd_t + ((size_t)ehi * DM + ct * 64 + cc) * DE; }, acc);
        if (valid) {
            const int tok = list[(size_t)bk * T + idx];
            const size_t o = (size_t)tok * DM + ct * 64 + cg * 8;
            const f32x4 h0 = *(const GAS f32x4*)(F.out + o), h1 = *(const GAS f32x4*)(F.out + o + 4);
            *(GAS f32x4*)(F.out + o) = (f32x4){h0.x + acc[0], h0.y + acc[1], h0.z + acc[2], h0.w + acc[3]};
            *(GAS f32x4*)(F.out + o + 4) = (f32x4){h1.x + acc[4], h1.y + acc[5], h1.z + acc[6], h1.w + acc[7]};
        }
    }
}

__global__ void __launch_bounds__(NTHR, 2) fwd_kernel(Args args) {
    extern __shared__ __attribute__((aligned(16))) unsigned char lds[];
    Frame F;
    F.lds = (LAS unsigned char*)lds;
    F.MISC = (volatile LAS unsigned*)(F.lds + MISC_OFF);
    F.tid = threadIdx.x; F.lane = F.tid & 63; F.wave = __builtin_amdgcn_readfirstlane(F.tid >> 6);
    F.G = gridDim.x; { const int bx = blockIdx.x; F.vcu = (F.G % 8 == 0) ? (bx % 8) * (F.G / 8) + bx / 8 : bx; }
    F.ws = args.ws; F.out = args.out; F.ctl = (gu32*)(args.ws + WS_CTL);
    for (int u = F.tid; u < (LDS_BYTES - LDSCTL_OFF) / 4; u += NTHR) ((LAS unsigned*)(F.lds + LDSCTL_OFF))[u] = 0u;
    __syncthreads();
    XcdBarrier bar; bar.bar = (unsigned*)(F.ctl + CW_BAR); bar.x = 0; bar.st = nullptr;
    if (N_LAUNCHES != PER_PHASE) bar = xcd_barrier_post((unsigned*)(F.ctl + CW_BAR), F.MISC + 8);
#define GRID_BAR() do { if (N_LAUNCHES != PER_PHASE) xcd_barrier(bar); } while (0)
    const int lo = args.ph_lo, hi = args.ph_hi;
#define IN(k) (lo <= (k) && (k) < hi)
#define BOTH(k) (IN(k) && IN((k) + 1))
    if (IN(0)) { p0_prologue(F, args); if (BOTH(0)) GRID_BAR(); }
    if (IN(1)) { p1_simple(F, args); if (BOTH(1)) GRID_BAR(); }
    if (IN(2)) { for (int i = F.vcu; i < BATCH * 32; i += F.G) lru_chunk<false>(F, args, i >> 5, i & 31); if (BOTH(2)) GRID_BAR(); }
    if (IN(3)) { p3_simple(F, args); if (BOTH(3)) GRID_BAR(); }
    if (IN(4)) { p4_simple(F, args); if (BOTH(4)) GRID_BAR(); }
    if (IN(5)) { p5_route(F, args); if (BOTH(5)) GRID_BAR(); }
    if (IN(6)) { p6_simple(F, args); if (BOTH(6)) GRID_BAR(); }
    if (IN(7)) { p7_simple(F, args); }
#undef IN
#undef BOTH
}

extern "C" void kernel_launch(void* const* d_in, const int* in_sizes, int n_in, void* d_out, int out_size, void* d_ws, size_t ws_size, hipStream_t stream) {
    static int grid = 0;
    if (grid == 0) {
        if (n_in != 27 || in_sizes[0] != T * DM || out_size != T * DM || ws_size < WS_END) {
            fprintf(stderr, "kernel_launch: unexpected shapes (n_in %d, in0 %d, out %d, ws %zu); nothing launched\n", n_in, n_in > 0 ? in_sizes[0] : -1, out_size, ws_size); grid = -1; return; }
        int dev = 0, cus = 0;
        if (hipGetDevice(&dev) != hipSuccess || hipDeviceGetAttribute(&cus, hipDeviceAttributeMultiprocessorCount, dev) != hipSuccess) { grid = -1; return; }
        if (hipFuncSetAttribute((const void*)fwd_kernel, hipFuncAttributeMaxDynamicSharedMemorySize, LDS_BYTES) != hipSuccess) { fprintf(stderr, "kernel_launch: hipFuncSetAttribute failed\n"); grid = -1; return; }
        (void)hipGetLastError();
        grid = cus;
    }
    if (grid < 0) return;
    if (hipMemsetAsync((char*)d_ws + WS_CTL, 0, CTL_ZERO_BYTES, stream) != hipSuccess) return;
    Args a{};
    for (int i = 0; i < 27; ++i) a.in[i] = (const float*)d_in[i];
    a.out = (float*)d_out; a.ws = (unsigned char*)d_ws;
    for (int li = 0; li < N_LAUNCHES; ++li) {
        a.ph_lo = (N_LAUNCHES == PER_PHASE) ? li : 0; a.ph_hi = (N_LAUNCHES == PER_PHASE) ? li + 1 : PER_PHASE; a.li = li;
        hipLaunchKernelGGL(fwd_kernel, dim3(grid), dim3(NTHR), LDS_BYTES, stream, a);
    }
}
```

```cpp
#include <hip/hip_runtime.h>
#include <cstdio>
#include <cstdint>

#ifndef MK_N_LAUNCHES
#define MK_N_LAUNCHES 1
#endif
constexpr int N_LAUNCHES = MK_N_LAUNCHES;
constexpr int PER_PHASE = 8;

#define GAS __attribute__((address_space(1)))
#define LAS __attribute__((address_space(3)))
typedef unsigned short bf16;
typedef unsigned v4u __attribute__((ext_vector_type(4)));
typedef unsigned v2u __attribute__((ext_vector_type(2)));
typedef float f32x4 __attribute__((ext_vector_type(4)));
typedef GAS unsigned gu32;
#define RLX_AGENT __ATOMIC_RELAXED, __HIP_MEMORY_SCOPE_AGENT
#define LDS_WAIT() asm volatile("s_waitcnt lgkmcnt(0)" ::: "memory")
#define VM_WAIT() asm volatile("s_waitcnt vmcnt(0)" ::: "memory")

constexpr int BATCH = 16, SEQ = 2048, DM = 1024, T = BATCH * SEQ;
constexpr int LW = 512, AW = 512, NH = 4, HD = 64, VD = 128, INC = 2560;
constexpr int NE = 16, DE = 512, NBK = 24;
constexpr float EPS = 1e-6f;
constexpr float LOG2E = 1.4426950408889634f;
constexpr float C2 = 0.125f * LOG2E;
constexpr int NWAVES = 8, NTHR = 512;

constexpr size_t MiB = 1u << 20;
constexpr size_t WS_CTL = 0, CTL_ZERO_BYTES = 1 * MiB;
constexpr size_t WS_WIN = 2 * MiB;
constexpr size_t WS_WOUT = 8 * MiB;
constexpr size_t WS_WG = 10 * MiB;
constexpr size_t WS_WU = 26 * MiB;
constexpr size_t WS_WD = 42 * MiB;
constexpr size_t WS_AGG = 58 * MiB;
constexpr size_t WS_GATES = 60 * MiB;
constexpr size_t WS_LIST = 61 * MiB;
constexpr size_t WS_XN = 64 * MiB;
constexpr size_t WS_XL = 128 * MiB;
constexpr size_t WS_GL = 160 * MiB;
constexpr size_t WS_Q = 192 * MiB;
constexpr size_t WS_K = 224 * MiB;
constexpr size_t WS_V = 256 * MiB;
constexpr size_t WS_Y = 288 * MiB;
constexpr size_t WS_HID = 128 * MiB;
constexpr int HID_ROWS = T + NBK * 256;
constexpr size_t WS_GPOS = 352 * MiB;
constexpr size_t WS_END = 360 * MiB;
static_assert(WS_HID + (size_t)HID_ROWS * 2048 <= WS_K, "hid overlay");
constexpr int CW_TMO = 0, CW_BAR = 4096, CW_CNT = 8192;

constexpr int SCR_BYTES = 143360;
constexpr int LDSCTL_OFF = SCR_BYTES, MISC_OFF = LDSCTL_OFF + 320;
constexpr int LDS_BYTES = 147456;

__device__ __forceinline__ unsigned f2bf(float f) { unsigned u = __builtin_bit_cast(unsigned, f); return (u + 0x7fffu + ((u >> 16) & 1u)) >> 16; }
__device__ __forceinline__ unsigned pk2(float lo, float hi) { return f2bf(lo) | (f2bf(hi) << 16); }
__device__ __forceinline__ float bf2f(bf16 b) { return __builtin_bit_cast(float, (unsigned)b << 16); }
__device__ __forceinline__ float bflo(unsigned w) { return __builtin_bit_cast(float, w << 16); }
__device__ __forceinline__ float bfhi(unsigned w) { return __builtin_bit_cast(float, w & 0xffff0000u); }
__device__ __forceinline__ float wave_sum(float v) {
#pragma unroll
    for (int o = 1; o < 64; o <<= 1) v += __shfl_xor(v, o);
    return v;
}
__device__ __forceinline__ float sigmoidf_(float x) { return 1.0f / (1.0f + __expf(-x)); }
__device__ __forceinline__ float gelu_tanh(float x) {
    const float z = 0.7978845608028654f * (x + 0.044715f * x * x * x);
    const float e = __expf(2.0f * z);
    const float th = 1.0f - 2.0f / (e + 1.0f);
    return 0.5f * x * (1.0f + th);
}

#define XB_TMO      128
#define XB_XCNT(j)  (256  + 64 * (j))
#define XB_XSUB(j)  (1280 + 64 * (j))
#define XB_XGEN(j)  (2304 + 64 * (j))
#define XB_TOP      3328
#define XB_TOPGEN   3392
#define XCD_BAR_WORDS 3456
#define XB_SPIN_CAP (1u << 18)
__device__ __forceinline__ unsigned xb_ld(unsigned* p)              { return __hip_atomic_load(p, __ATOMIC_RELAXED, __HIP_MEMORY_SCOPE_AGENT); }
__device__ __forceinline__ unsigned xb_add(unsigned* p, unsigned v) { return __hip_atomic_fetch_add(p, v, __ATOMIC_RELAXED, __HIP_MEMORY_SCOPE_AGENT); }
__device__ __forceinline__ unsigned xb_xcc_id() { return (unsigned)__builtin_amdgcn_s_getreg((3 << 11) | 20) & 0xFu; }
#define XB_SPIN(cond, bar) do { unsigned _sp = 0; while (cond) { __builtin_amdgcn_s_sleep(1); \
    if ((++_sp & 255u) == 0u) { if (xb_ld(&(bar)[XB_TMO])) break; if (_sp > XB_SPIN_CAP) { atomicAdd(&(bar)[XB_TMO], 1u); break; } } } } while (0)
struct XcdBarrier { unsigned* bar; unsigned x; volatile LAS unsigned* st; };
__device__ __forceinline__ XcdBarrier xcd_barrier_post(unsigned* bar, volatile LAS unsigned* st) {
    XcdBarrier b; b.bar = bar; b.x = xb_xcc_id(); b.st = st;
    if (threadIdx.x == 0) (void)xb_add(&bar[XB_XCNT(b.x)], 1u);
    return b;
}
__device__ __forceinline__ void xcd_barrier_complete(unsigned* bar, unsigned x, unsigned& nloc, unsigned& nx) {
    const unsigned G = gridDim.x * gridDim.y * gridDim.z;
    unsigned sum, cnt, mine, sp = 0u;
    for (;;) {
        sum = 0u; cnt = 0u; mine = 0u;
#pragma unroll
        for (unsigned j = 0; j < 16; ++j) { const unsigned c = xb_ld(&bar[XB_XCNT(j)]); sum += c; cnt += (c > 0u) ? 1u : 0u; mine = (j == x) ? c : mine; }
        if (sum == G) break;
        __builtin_amdgcn_s_sleep(1);
        if ((++sp & 255u) == 0u) { if (xb_ld(&bar[XB_TMO])) break; if (sp > XB_SPIN_CAP) { atomicAdd(&bar[XB_TMO], 1u); break; } }
    }
    nloc = mine > 0u ? mine : 1u; nx = cnt > 0u ? cnt : 1u;
}
__device__ __forceinline__ void xcd_barrier(const XcdBarrier& b) {
    asm volatile("s_waitcnt vmcnt(0)" ::: "memory");
    __syncthreads();
    if (threadIdx.x == 0) {
        unsigned* bar = b.bar;
        __builtin_amdgcn_s_waitcnt(0);
        unsigned nloc = b.st[0], nx = b.st[1];
        if (nloc == 0u) { xcd_barrier_complete(bar, b.x, nloc, nx); b.st[0] = nloc; b.st[1] = nx; }
        const unsigned old = xb_add(&bar[XB_XSUB(b.x)], 1u);
        const unsigned gen = old / nloc;
        if (old + 1u == (gen + 1u) * nloc) {
            __builtin_amdgcn_fence(__ATOMIC_RELEASE, "agent");
            asm volatile("s_waitcnt vmcnt(0)" ::: "memory");
            const unsigned og = xb_add(&bar[XB_TOP], 1u);
            const unsigned tg = og / nx;
            if (og + 1u == (tg + 1u) * nx) xb_add(&bar[XB_TOPGEN], 1u);
            else XB_SPIN(xb_ld(&bar[XB_TOPGEN]) == tg, bar);
            __builtin_amdgcn_fence(__ATOMIC_ACQUIRE, "agent");
            xb_add(&bar[XB_XGEN(b.x)], 1u);
            asm volatile("s_waitcnt vmcnt(0)" ::: "memory");
        } else {
            XB_SPIN(xb_ld(&bar[XB_XGEN(b.x)]) == gen, bar);
            __builtin_amdgcn_fence(__ATOMIC_ACQUIRE, "agent");
            asm volatile("s_waitcnt vmcnt(0)" ::: "memory");
        }
    }
    __syncthreads();
}

struct Args { const float* in[27]; float* out; unsigned char* ws; int ph_lo, ph_hi, li, pad; };
struct Frame {
    LAS unsigned char* lds; volatile LAS unsigned* MISC; gu32* ctl;
    int tid, lane, wave, vcu, G;
    unsigned char* ws; float* out;
};

__device__ __forceinline__ void p0_transpose_item(const float* W, int K, int N, bf16* WT, LAS float* scr, int item, int lane) {
    const int nblk = N / 32, kb = item / nblk, nb = item % nblk, k0 = 64 * kb, n0 = 32 * nb;
#pragma unroll 8
    for (int i = 0; i < 32; ++i) { const int kk = 2 * i + (lane >> 5); scr[kk * 33 + (lane & 31)] = W[(size_t)(k0 + kk) * N + n0 + (lane & 31)]; }
    LDS_WAIT(); asm volatile("" ::: "memory");
    const int c = lane & 7;
#pragma unroll
    for (int j = 0; j < 4; ++j) { const int n = (lane >> 3) + 8 * j; const LAS float* s = scr + (8 * c) * 33 + n;
        v4u o; o.x = pk2(s[0 * 33], s[1 * 33]); o.y = pk2(s[2 * 33], s[3 * 33]); o.z = pk2(s[4 * 33], s[5 * 33]); o.w = pk2(s[6 * 33], s[7 * 33]);
        *(GAS v4u*)(WT + (size_t)(n0 + n) * K + k0 + 8 * c) = o; }
    LDS_WAIT(); asm volatile("" ::: "memory");
}
__device__ __forceinline__ void rms_row_to_bf16(const float* xrow, const float* g, bf16* orow, int lane) {
    const GAS f32x4* xr = (const GAS f32x4*)xrow + lane;
    const GAS f32x4* gr = (const GAS f32x4*)g + lane;
    f32x4 v[4]; float s = 0.f;
#pragma unroll
    for (int j = 0; j < 4; ++j) { v[j] = xr[64 * j]; s += (v[j].x * v[j].x + v[j].y * v[j].y) + (v[j].z * v[j].z + v[j].w * v[j].w); }
    const float r = 1.0f / sqrtf(wave_sum(s) * (1.0f / DM) + EPS);
    GAS v2u* o8 = (GAS v2u*)orow + lane;
#pragma unroll
    for (int j = 0; j < 4; ++j) { const f32x4 gg = gr[64 * j]; v2u w; w.x = pk2(v[j].x * r * gg.x, v[j].y * r * gg.y); w.y = pk2(v[j].z * r * gg.z, v[j].w * r * gg.w); o8[64 * j] = w; }
}
__device__ __forceinline__ void p0_prologue(Frame& F, const Args& a) {
    LAS float* scr = (LAS float*)(F.lds + F.wave * 16384);
    const int gw = F.vcu * NWAVES + F.wave, NGW = F.G * NWAVES;
    constexpr int I_IN = (DM / 64) * (INC / 32), I_OUT = (DM / 64) * (DM / 32), I_E = 256;
    constexpr int NITEMS = I_IN + I_OUT + 3 * NE * I_E;
    bf16* Win_t = (bf16*)(F.ws + WS_WIN); bf16* Wout_t = (bf16*)(F.ws + WS_WOUT);
    bf16* Wg_t = (bf16*)(F.ws + WS_WG); bf16* Wu_t = (bf16*)(F.ws + WS_WU); bf16* Wd_t = (bf16*)(F.ws + WS_WD);
    for (int it = gw; it < NITEMS; it += NGW) {
        int r = it;
        if (r < I_IN) { p0_transpose_item(a.in[2], DM, INC, Win_t, scr, r, F.lane); continue; } r -= I_IN;
        if (r < I_OUT) { p0_transpose_item(a.in[18], DM, DM, Wout_t, scr, r, F.lane); continue; } r -= I_OUT;
        if (r < NE * I_E) { const int e = r / I_E; p0_transpose_item(a.in[24] + (size_t)e * DM * DE, DM, DE, Wg_t + (size_t)e * DE * DM, scr, r % I_E, F.lane); continue; } r -= NE * I_E;
        if (r < NE * I_E) { const int e = r / I_E; p0_transpose_item(a.in[25] + (size_t)e * DM * DE, DM, DE, Wu_t + (size_t)e * DE * DM, scr, r % I_E, F.lane); continue; } r -= NE * I_E;
        { const int e = r / I_E; p0_transpose_item(a.in[26] + (size_t)e * DE * DM, DE, DM, Wd_t + (size_t)e * DM * DE, scr, r % I_E, F.lane); }
    }
    bf16* XN = (bf16*)(F.ws + WS_XN);
    for (int m = gw; m < T; m += NGW) rms_row_to_bf16(a.in[0] + (size_t)m * DM, a.in[1], XN + (size_t)m * DM, F.lane);
}

template <class AF, class BF>
__device__ __forceinline__ void ngemm_acc(LAS float* As, LAS float* Bs, int K, AF arow, BF bcol, float (&acc)[8]) {
    const int tid = threadIdx.x, r = tid >> 3, cg = tid & 7;
    const bf16* ap = arow(r); const bf16* bp = bcol(r);
    for (int k0 = 0; k0 < K; k0 += 64) {
        __syncthreads();
        const v4u va = *(const GAS v4u*)(ap + k0 + cg * 8);
        const v4u vb = *(const GAS v4u*)(bp + k0 + cg * 8);
#pragma unroll
        for (int j = 0; j < 4; ++j) {
            As[r * 65 + cg * 8 + 2 * j] = bflo(va[j]); As[r * 65 + cg * 8 + 2 * j + 1] = bfhi(va[j]);
            Bs[(cg * 8 + 2 * j) * 72 + r] = bflo(vb[j]); Bs[(cg * 8 + 2 * j + 1) * 72 + r] = bfhi(vb[j]);
        }
        __syncthreads();
#pragma unroll 8
        for (int kk = 0; kk < 64; ++kk) {
            const float av = As[r * 65 + kk];
            const f32x4 b0 = *(const LAS f32x4*)&Bs[kk * 72 + cg * 8], b1 = *(const LAS f32x4*)&Bs[kk * 72 + cg * 8 + 4];
            acc[0] += av * b0.x; acc[1] += av * b0.y; acc[2] += av * b0.z; acc[3] += av * b0.w;
            acc[4] += av * b1.x; acc[5] += av * b1.y; acc[6] += av * b1.z; acc[7] += av * b1.w;
        }
    }
}
__device__ __forceinline__ v4u pack8(const float (&v)[8]) { v4u o; o.x = pk2(v[0], v[1]); o.y = pk2(v[2], v[3]); o.z = pk2(v[4], v[5]); o.w = pk2(v[6], v[7]); return o; }
__device__ __forceinline__ float sum8lanes(float v) { v += __shfl_xor(v, 1); v += __shfl_xor(v, 2); v += __shfl_xor(v, 4); return v; }
__device__ __forceinline__ float max8lanes(float v) { v = fmaxf(v, __shfl_xor(v, 1)); v = fmaxf(v, __shfl_xor(v, 2)); v = fmaxf(v, __shfl_xor(v, 4)); return v; }

__device__ __forceinline__ void p1_simple(Frame& F, const Args& a) {
    LAS float* As = (LAS float*)F.lds; LAS float* Bs = As + 64 * 65;
    const bf16* XN = (const bf16*)(F.ws + WS_XN); const bf16* Win_t = (const bf16*)(F.ws + WS_WIN);
    const int tid = F.tid, r = tid >> 3, cg = tid & 7;
    constexpr int NCT = INC / 64;
    for (int tt = F.vcu; tt < (T / 64) * NCT; tt += F.G) {
        const int rt = tt / NCT, ct = tt % NCT;
        float acc[8] = {0.f, 0.f, 0.f, 0.f, 0.f, 0.f, 0.f, 0.f};
        ngemm_acc(As, Bs, DM, [&](int rr) { return XN + (size_t)(rt * 64 + rr) * DM; }, [&](int cc) { return Win_t + (size_t)(ct * 64 + cc) * DM; }, acc);
        const int region = ct >> 3, lc0 = (ct & 7) * 64 + cg * 8; const size_t row = (size_t)rt * 64 + r;
        bf16* dst = (bf16*)(F.ws + WS_XL + (size_t)region * 32 * MiB) + row * 512 + lc0;
        if (region == 1) {
#pragma unroll
            for (int j = 0; j < 8; ++j) acc[j] = gelu_tanh(acc[j]);
        } else if (region == 2 || region == 3) {
            float ss = 0.f;
#pragma unroll
            for (int j = 0; j < 8; ++j) ss += acc[j] * acc[j];
            ss = sum8lanes(ss);
            const float rr = (1.0f / sqrtf(ss * (1.0f / HD) + EPS)) * (region == 2 ? C2 : 1.0f);
            const float* g = a.in[region == 2 ? 11 : 12] + cg * 8;
#pragma unroll
            for (int j = 0; j < 8; ++j) acc[j] = acc[j] * rr * g[j];
        }
        *(GAS v4u*)dst = pack8(acc);
    }
}


namespace pg8 {
typedef short bf16x8 __attribute__((ext_vector_type(8)));
constexpr int BM = 256, BK = 64, HALF = 128, HTB = HALF * BK * 2, STAGE_BYTES = 8 * HTB;
__host__ __device__ __forceinline__ int lds_byte(int r, int c) { const int st = (r >> 4) * 2 + (c >> 5), rr = r & 15, cc = c & 31, ob = rr * 64 + cc * 2; return st * 1024 + (ob ^ (((ob >> 9) & 1) << 5)); }
__host__ __device__ __forceinline__ void stage_rc(int b, int& R, int& C) { const int st = b / 1024, sb = b % 1024, swz = sb ^ (((sb >> 9) & 1) << 5); R = (st >> 1) * 16 + swz / 64; C = (st & 1) * 32 + (swz % 64) / 2; }
__host__ __device__ __forceinline__ int perm32(int rho) { const int n = rho >> 4, i = rho & 15; return 8 * (i >> 2) + 4 * n + (i & 3); }
enum { MAP_NAT = 0, MAP_P32 = 1, MAP_G64 = 2 };
__device__ __forceinline__ int bmap_row(int map, int R) { return map == MAP_NAT ? R : (map == MAP_P32 ? 32 * (R >> 5) + perm32(R & 31) : 64 * (R >> 5) + perm32(R & 31)); }

struct GUnit { const char* A; const char* B; const char* B2; int pm, pn, e0, e1; };

struct GemmCfg { int nt, kseg; unsigned lda, ldb; size_t hstepA, hstepB; int bmap; const int* glist; };

template <class Epi, class Sched, bool GATHER, bool SEGB>
__device__ __forceinline__ void gemm_phase(LAS unsigned char* lds, const GemmCfg g, const Sched& S, const Epi& E) {
    const int tid = threadIdx.x, wid = __builtin_amdgcn_readfirstlane(tid >> 6), lane = tid & 63, wr = wid >> 2, wc = wid & 3, fr = lane & 15, fq = lane >> 4;
    const int nt = g.nt;
    unsigned voffA[2], voffB[2]; int RA[2];
#pragma unroll
    for (int i = 0; i < 2; ++i) { int R, C; stage_rc(tid * 16 + i * 8192, R, C); RA[i] = R;
        voffA[i] = GATHER ? (unsigned)(C * 2) : (unsigned)R * g.lda + (unsigned)(C * 2); voffB[i] = (unsigned)bmap_row(g.bmap, R) * g.ldb + (unsigned)(C * 2); }
    const size_t kstep = (size_t)(BK * 2);
    const size_t hstepA = g.hstepA, hstepB = g.hstepB;
    const unsigned ldsw = (unsigned)wid * 1024u;
    const int aoff = lds_byte(wr * 64 + fr, fq * 8), boff = lds_byte(wc * 32 + fr, fq * 8);
#define PG8_SA(b, h) (((b) * 2 + (h)) * HTB)
#define PG8_SB(b, h) ((4 + (b) * 2 + (h)) * HTB)
#define PG8_STAGE(bufoff, gbase, voff) do { _Pragma("unroll") for (int _i = 0; _i < 2; ++_i) \
        __builtin_amdgcn_global_load_lds((const unsigned*)((const char*)(gbase) + (voff)[_i]), (LAS unsigned*)(lds + (bufoff) + ldsw + _i * 8192), 16, 0, 0); } while (0)
#define PG8_LDA(dst, b, h) do { _Pragma("unroll") for (int m = 0; m < 4; ++m) _Pragma("unroll") for (int k = 0; k < 2; ++k) dst[m][k] = *(const LAS bf16x8*)(lds + PG8_SA(b, h) + aoff + m * 2048 + k * 1024); } while (0)
#define PG8_LDB(dst, b, h) do { _Pragma("unroll") for (int n = 0; n < 2; ++n) _Pragma("unroll") for (int k = 0; k < 2; ++k) dst[n][k] = *(const LAS bf16x8*)(lds + PG8_SB(b, h) + boff + n * 2048 + k * 1024); } while (0)
#define PG8_MMA(ai, bj, At, Bt) do { __builtin_amdgcn_s_setprio(1); _Pragma("unroll") for (int m = 0; m < 4; ++m) _Pragma("unroll") for (int n = 0; n < 2; ++n) _Pragma("unroll") for (int k = 0; k < 2; ++k) \
        acc[ai][bj][m][n] = __builtin_amdgcn_mfma_f32_16x16x32_bf16(Bt[n][k], At[m][k], acc[ai][bj][m][n], 0, 0, 0); __builtin_amdgcn_s_setprio(0); } while (0)
#define PG8_WAIT_V(n) asm volatile("s_waitcnt vmcnt(" #n ")" ::: "memory")
#define PG8_WAIT_L(n) asm volatile("s_waitcnt lgkmcnt(" #n ")" ::: "memory")
#define PG8_BAR __builtin_amdgcn_s_barrier()
#define PG8_SCHED __builtin_amdgcn_sched_barrier(0)
    GUnit cur, nxt; int ui = 0;
    if (!S.next(0, cur)) return;
    f32x4 acc[2][2][4][2];
#pragma unroll
    for (int a = 0; a < 2; ++a)
#pragma unroll
        for (int b = 0; b < 2; ++b)
#pragma unroll
            for (int m = 0; m < 4; ++m)
#pragma unroll
                for (int n = 0; n < 2; ++n) acc[a][b][m][n] = (f32x4){0.f, 0.f, 0.f, 0.f};
    bf16x8 At[4][2], B0[2][2], B1[2][2];
    unsigned vg0[2], vg1[2];
    auto load_gather = [&](const GUnit& u, unsigned (&o0)[2], unsigned (&o1)[2]) {
#pragma unroll
        for (int i = 0; i < 2; ++i) {
            const int r0 = RA[i], r1 = 128 + RA[i];
            const int t0 = g.glist[u.pm + (r0 < u.e1 ? u.e0 + r0 : 0)], t1 = g.glist[u.pm + (r1 < u.e1 ? u.e0 + r1 : 0)];
            o0[i] = (unsigned)t0 * g.lda + voffA[i]; o1[i] = (unsigned)t1 * g.lda + voffA[i];
        }
    };
    const char* cA = cur.A; const char* cB = cur.B; const char* cB2 = cur.B2;
    if constexpr (GATHER) load_gather(cur, vg0, vg1);
#define PG8_A0(base, kt) (GATHER ? (base) + (size_t)(kt) * kstep : (base) + (size_t)(kt) * kstep)
#define PG8_STAGE_A0(bufoff, base, kt) do { if constexpr (GATHER) PG8_STAGE(bufoff, (base) + (size_t)(kt) * kstep, vg0); else PG8_STAGE(bufoff, (base) + (size_t)(kt) * kstep, voffA); } while (0)
#define PG8_STAGE_A1(bufoff, base, kt) do { if constexpr (GATHER) PG8_STAGE(bufoff, (base) + (size_t)(kt) * kstep, vg1); else PG8_STAGE(bufoff, (base) + hstepA + (size_t)(kt) * kstep, voffA); } while (0)
#define PG8_BP(B_, B2_, kt) ((SEGB && (kt) >= g.kseg) ? (B2_) + (size_t)((kt) - g.kseg) * kstep : (B_) + (size_t)(kt) * kstep)
    PG8_STAGE(PG8_SB(0, 0), cB, voffB); PG8_STAGE(PG8_SB(0, 1), cB + hstepB, voffB); PG8_STAGE_A0(PG8_SA(0, 0), cA, 0); PG8_STAGE_A1(PG8_SA(0, 1), cA, 0);
    if (wr == 1) PG8_BAR;
    PG8_WAIT_V(2); PG8_BAR;
    PG8_STAGE(PG8_SB(1, 0), cB + kstep, voffB); PG8_STAGE_A0(PG8_SA(1, 0), cA, 1); PG8_STAGE(PG8_SB(1, 1), cB + hstepB + kstep, voffB);
    PG8_WAIT_V(6); PG8_BAR;
    for (;;) {
        const bool has_next = S.next(ui + 1, nxt);
        const char* nA = has_next ? nxt.A : cA; const char* nB = has_next ? nxt.B : cB; const char* nB2 = has_next ? nxt.B2 : cB2;
        for (int t = 0; t < nt; t += 2) {
            const bool last = (t == nt - 2);
            unsigned ng0[2], ng1[2];
            if constexpr (GATHER) { if (last) { if (has_next) load_gather(nxt, ng0, ng1); else { ng0[0] = vg0[0]; ng0[1] = vg0[1]; ng1[0] = vg1[0]; ng1[1] = vg1[1]; } } }
            const char* b2 = last ? PG8_BP(nB, nB2, 0) : PG8_BP(cB, cB2, t + 2);
            const char* b3 = last ? PG8_BP(nB, nB2, 1) : PG8_BP(cB, cB2, t + 3);
            const char* a23 = last ? nA : cA; const int k2 = last ? 0 : t + 2, k3 = last ? 1 : t + 3;
            PG8_LDB(B0, 0, 0); PG8_LDB(B1, 0, 1); PG8_SCHED; PG8_LDA(At, 0, 0); PG8_STAGE_A1(PG8_SA(1, 1), cA, t + 1);
            PG8_WAIT_V(8); PG8_WAIT_L(0); PG8_BAR; PG8_MMA(0, 0, At, B0); PG8_MMA(0, 1, At, B1); PG8_BAR; PG8_SCHED;
            if constexpr (GATHER) { if (last) { vg0[0] = ng0[0]; vg0[1] = ng0[1]; vg1[0] = ng1[0]; vg1[1] = ng1[1]; } }
            PG8_LDA(At, 0, 1); PG8_STAGE(PG8_SB(0, 0), b2, voffB); PG8_STAGE(PG8_SB(0, 1), b2 + hstepB, voffB); PG8_STAGE_A0(PG8_SA(0, 0), a23, k2);
            PG8_WAIT_V(8); PG8_WAIT_L(0); PG8_BAR; PG8_MMA(1, 0, At, B0); PG8_MMA(1, 1, At, B1); PG8_BAR; PG8_SCHED;
            PG8_LDB(B0, 1, 0); PG8_LDB(B1, 1, 1); PG8_SCHED; PG8_LDA(At, 1, 0); PG8_STAGE_A1(PG8_SA(0, 1), a23, k2);
            PG8_WAIT_V(8); PG8_WAIT_L(0); PG8_BAR; PG8_MMA(0, 0, At, B0); PG8_MMA(0, 1, At, B1); PG8_BAR; PG8_SCHED;
            PG8_LDA(At, 1, 1); PG8_STAGE(PG8_SB(1, 0), b3, voffB); PG8_STAGE(PG8_SB(1, 1), b3 + hstepB, voffB); PG8_STAGE_A0(PG8_SA(1, 0), a23, k3);
            PG8_WAIT_V(8); PG8_WAIT_L(0); PG8_BAR; PG8_MMA(1, 0, At, B0); PG8_MMA(1, 1, At, B1); PG8_BAR; PG8_SCHED;
        }
        if (wr == 0) PG8_BAR;
        E(acc, cur, wr, wc, fr, fq);
        if (!has_next) break;
#pragma unroll
        for (int a = 0; a < 2; ++a)
#pragma unroll
            for (int b = 0; b < 2; ++b)
#pragma unroll
                for (int m = 0; m < 4; ++m)
#pragma unroll
                    for (int n = 0; n < 2; ++n) acc[a][b][m][n] = (f32x4){0.f, 0.f, 0.f, 0.f};
        cur = nxt; cA = nA; cB = nB; cB2 = nB2; ++ui;
        if (wr == 1) PG8_BAR;
    }
    PG8_WAIT_V(0);
    PG8_BAR;
#undef PG8_SA
#undef PG8_SB
#undef PG8_STAGE
#undef PG8_LDA
#undef PG8_LDB
#undef PG8_MMA
#undef PG8_WAIT_V
#undef PG8_WAIT_L
#undef PG8_BAR
#undef PG8_SCHED
#undef PG8_A0
#undef PG8_STAGE_A0
#undef PG8_STAGE_A1
#undef PG8_BP
}
struct TileOrder {
    int nM, nN, G, c; const char* A; const char* B; size_t tstepA, tstepB;
    __device__ __forceinline__ bool next(int i, GUnit& u) const {
        const int L = i * G + c; if (L >= nM * nN) return false;
        const int nig = 8 * nN, gid = L / nig, fm = gid * 8, gsz = (nM - fm) < 8 ? (nM - fm) : 8;
        u.pm = fm + ((L % nig) % gsz); u.pn = (L % nig) / gsz; u.A = A + (size_t)u.pm * tstepA; u.B = B + (size_t)u.pn * tstepB; u.B2 = nullptr; u.e0 = 0; u.e1 = 0; return true;
    }
};
__device__ __forceinline__ unsigned cvt_pk_bf16(float lo, float hi) { unsigned r; asm volatile("v_cvt_pk_bf16_f32 %0, %1, %2" : "=v"(r) : "v"(lo), "v"(hi)); return r; }
}

struct EpiProj {
    unsigned char* ws; const float* qg; const float* kg;
    __device__ __forceinline__ void operator()(const f32x4 (&acc)[2][2][4][2], const pg8::GUnit& u, int wr, int wc, int fr, int fq) const {
        const int region = u.pn >> 1, lc0 = (u.pn & 1) * 256 + 64 * wc + 8 * fq;
        bf16* base = (bf16*)(ws + WS_XL + (size_t)region * 32 * MiB);
        f32x4 gv[2][2];
        if (region == 2 || region == 3) {
            const float* g = (region == 2 ? qg : kg) + 8 * fq;
#pragma unroll
            for (int bj = 0; bj < 2; ++bj)
#pragma unroll
                for (int n = 0; n < 2; ++n) gv[bj][n] = *(const GAS f32x4*)(g + 32 * bj + 4 * n);
        }
#pragma unroll
        for (int ai = 0; ai < 2; ++ai)
#pragma unroll
            for (int m = 0; m < 4; ++m) {
                const size_t row = (size_t)u.pm * 256 + ai * 128 + wr * 64 + m * 16 + fr;
                f32x4 v[2][2];
#pragma unroll
                for (int bj = 0; bj < 2; ++bj)
#pragma unroll
                    for (int n = 0; n < 2; ++n) v[bj][n] = acc[ai][bj][m][n];
                if (region == 1) {
#pragma unroll
                    for (int bj = 0; bj < 2; ++bj)
#pragma unroll
                        for (int n = 0; n < 2; ++n) { v[bj][n].x = gelu_tanh(v[bj][n].x); v[bj][n].y = gelu_tanh(v[bj][n].y); v[bj][n].z = gelu_tanh(v[bj][n].z); v[bj][n].w = gelu_tanh(v[bj][n].w); }
                } else if (region == 2 || region == 3) {
                    float ss = 0.f;
#pragma unroll
                    for (int bj = 0; bj < 2; ++bj)
#pragma unroll
                        for (int n = 0; n < 2; ++n) ss += (v[bj][n].x * v[bj][n].x + v[bj][n].y * v[bj][n].y) + (v[bj][n].z * v[bj][n].z + v[bj][n].w * v[bj][n].w);
                    ss += __shfl_xor(ss, 16); ss += __shfl_xor(ss, 32);
                    const float rr = (1.0f / sqrtf(ss * (1.0f / HD) + EPS)) * (region == 2 ? C2 : 1.0f);
#pragma unroll
                    for (int bj = 0; bj < 2; ++bj)
#pragma unroll
                        for (int n = 0; n < 2; ++n) v[bj][n] = v[bj][n] * rr * gv[bj][n];
                }
                bf16* rowp = base + row * 512 + lc0;
#pragma unroll
                for (int bj = 0; bj < 2; ++bj) { v4u w; w.x = pg8::cvt_pk_bf16(v[bj][0].x, v[bj][0].y); w.y = pg8::cvt_pk_bf16(v[bj][0].z, v[bj][0].w); w.z = pg8::cvt_pk_bf16(v[bj][1].x, v[bj][1].y); w.w = pg8::cvt_pk_bf16(v[bj][1].z, v[bj][1].w);
                    *(GAS v4u*)(rowp + 32 * bj) = w; }
            }
    }
};
__device__ __forceinline__ void p1_fast(Frame& F, const Args& a) {
    pg8::GemmCfg g; g.nt = DM / 64; g.kseg = g.nt; g.lda = DM * 2; g.ldb = DM * 2; g.hstepA = (size_t)128 * DM * 2; g.hstepB = (size_t)32 * DM * 2; g.bmap = pg8::MAP_G64; g.glist = nullptr;
    pg8::TileOrder S; S.nM = T / 256; S.nN = INC / 256; S.G = F.G; S.c = F.vcu; S.A = (const char*)(F.ws + WS_XN); S.B = (const char*)(F.ws + WS_WIN); S.tstepA = (size_t)256 * DM * 2; S.tstepB = (size_t)256 * DM * 2;
    EpiProj E; E.ws = F.ws; E.qg = a.in[11]; E.kg = a.in[12];
    pg8::gemm_phase<EpiProj, pg8::TileOrder, false, false>(F.lds, g, S, E);
}

template <bool APPLY>
__device__ __forceinline__ void lru_chunk(Frame& F, const Args& a, int b, int j) {
    LAS float* XC = (LAS float*)F.lds;
    const int ch = F.tid; const size_t row0 = (size_t)b * SEQ + (size_t)j * 64;
    const bf16* XL = (const bf16*)(F.ws + WS_XL); const bf16* GL = (const bf16*)(F.ws + WS_GL);
    float* AGG = (float*)(F.ws + WS_AGG);
    __syncthreads();
    {
        const float cw0 = a.in[3][ch], cw1 = a.in[3][512 + ch], cw2 = a.in[3][1024 + ch], cw3 = a.in[3][1536 + ch], cb = a.in[4][ch];
        float x0 = 0.f, x1 = 0.f, x2 = 0.f;
        if (j > 0) { x0 = bf2f(XL[(row0 - 3) * 512 + ch]); x1 = bf2f(XL[(row0 - 2) * 512 + ch]); x2 = bf2f(XL[(row0 - 1) * 512 + ch]); }
#pragma unroll 8
        for (int t = 0; t < 64; ++t) {
            const float x3 = bf2f(XL[(row0 + t) * 512 + ch]);
            XC[t * 512 + ch] = cb + cw0 * x0 + cw1 * x1 + cw2 * x2 + cw3 * x3;
            x0 = x1; x1 = x2; x2 = x3;
        }
    }
    __syncthreads();
    float ra[64], ri[64];
#pragma unroll
    for (int t = 0; t < 64; ++t) { ra[t] = 0.f; ri[t] = 0.f; }
    {
        const int blk = ch >> 6, d = ch & 63;
        const float* Wa = a.in[5] + blk * 4096 + d; const float* Wx = a.in[7] + blk * 4096 + d;
        const LAS float* xb = XC + blk * 64;
#pragma unroll 1
        for (int c = 0; c < 64; c += 4) {
            const float wa0 = Wa[(c + 0) * 64], wa1 = Wa[(c + 1) * 64], wa2 = Wa[(c + 2) * 64], wa3 = Wa[(c + 3) * 64];
            const float wx0 = Wx[(c + 0) * 64], wx1 = Wx[(c + 1) * 64], wx2 = Wx[(c + 2) * 64], wx3 = Wx[(c + 3) * 64];
#pragma unroll
            for (int t = 0; t < 64; ++t) {
                const f32x4 xv = *(const LAS f32x4*)&xb[t * 512 + c];
                ra[t] += xv.x * wa0 + xv.y * wa1 + xv.z * wa2 + xv.w * wa3;
                ri[t] += xv.x * wx0 + xv.y * wx1 + xv.z * wx2 + xv.w * wx3;
            }
        }
    }
    __syncthreads();
    const float sp = log1pf(expf(-a.in[9][ch]));
    const float ba = a.in[6][ch], bx = a.in[8][ch];
    float h = 0.f, lasum = 0.f;
    if (APPLY) {
        for (int i = 0; i < j; ++i) { const float A = AGG[((size_t)(b * 32 + i) * 2 + 0) * 512 + ch], H = AGG[((size_t)(b * 32 + i) * 2 + 1) * 512 + ch]; h = A * h + H; }
    }
#pragma unroll
    for (int t = 0; t < 64; ++t) {
        const float xc = XC[t * 512 + ch];
        const float rg = sigmoidf_(ra[t] + ba), ig = sigmoidf_(ri[t] + bx);
        const float la = -8.0f * rg * sp;
        const float av = expf(la);
        const float u = sqrtf(-expm1f(2.0f * la)) * (ig * xc);
        h = av * h + u;
        if (APPLY) XC[t * 512 + ch] = h * bf2f(GL[(row0 + t) * 512 + ch]);
        else lasum += la;
    }
    if (!APPLY) {
        AGG[((size_t)(b * 32 + j) * 2 + 0) * 512 + ch] = expf(lasum);
        AGG[((size_t)(b * 32 + j) * 2 + 1) * 512 + ch] = h;
        return;
    }
    __syncthreads();
    bf16* Y = (bf16*)(F.ws + WS_Y);
    const f32x4 g0 = *(const GAS f32x4*)(a.in[10] + F.lane * 8), g1 = *(const GAS f32x4*)(a.in[10] + F.lane * 8 + 4);
#pragma unroll
    for (int i = 0; i < 8; ++i) {
        const int t = F.wave + 8 * i;
        const f32x4 y0 = *(const LAS f32x4*)&XC[t * 512 + F.lane * 8], y1 = *(const LAS f32x4*)&XC[t * 512 + F.lane * 8 + 4];
        float ss = (y0.x * y0.x + y0.y * y0.y) + (y0.z * y0.z + y0.w * y0.w) + (y1.x * y1.x + y1.y * y1.y) + (y1.z * y1.z + y1.w * y1.w);
        const float r = 1.0f / sqrtf(wave_sum(ss) * (1.0f / LW) + EPS);
        v4u o; o.x = pk2(y0.x * r * g0.x, y0.y * r * g0.y); o.y = pk2(y0.z * r * g0.z, y0.w * r * g0.w); o.z = pk2(y1.x * r * g1.x, y1.y * r * g1.y); o.w = pk2(y1.z * r * g1.z, y1.w * r * g1.w);
        *(GAS v4u*)(Y + (row0 + t) * DM + F.lane * 8) = o;
    }
}

__device__ __forceinline__ void nattn_unit(Frame& F, const Args& a, int b, int h, int c, float lam) {
    LAS float* Qs = (LAS float*)F.lds; LAS float* Ks = Qs + 64 * 132; LAS float* Vs = Ks + 64 * 132; LAS float* Ps = Vs + 64 * 132;
    const bf16* Qg = (const bf16*)(F.ws + WS_Q); const bf16* Kg = (const bf16*)(F.ws + WS_K); const bf16* Vg = (const bf16*)(F.ws + WS_V);
    const int tid = F.tid, qi = tid >> 3, sub = tid & 7;
    const float slope2 = exp2f(-2.0f * (float)(h + 1)) * LOG2E;
    __syncthreads();
    {
        const bf16* src = Qg + ((size_t)b * SEQ + 64 * c + qi) * 512 + h * 128 + sub * 16;
        const v4u v0 = *(const GAS v4u*)src, v1 = *(const GAS v4u*)(src + 8);
        LAS float* d = Qs + qi * 132 + sub * 16;
#pragma unroll
        for (int i = 0; i < 4; ++i) { d[2 * i] = bflo(v0[i]); d[2 * i + 1] = bfhi(v0[i]); d[8 + 2 * i] = bflo(v1[i]); d[8 + 2 * i + 1] = bfhi(v1[i]); }
    }
    float m0 = -1e30f, m1 = -1e30f, l0 = 0.f, l1 = 0.f, O0[16], O1[16];
#pragma unroll
    for (int i = 0; i < 16; ++i) { O0[i] = 0.f; O1[i] = 0.f; }
    for (int kt = 0; kt <= c; ++kt) {
        __syncthreads();
        {
            const size_t off = ((size_t)b * SEQ + 64 * kt + qi) * 512 + h * 128 + sub * 16;
            const v4u k0 = *(const GAS v4u*)(Kg + off), k1 = *(const GAS v4u*)(Kg + off + 8);
            const v4u v0 = *(const GAS v4u*)(Vg + off), v1 = *(const GAS v4u*)(Vg + off + 8);
            LAS float* dk = Ks + qi * 132 + sub * 16; LAS float* dv = Vs + qi * 132 + sub * 16;
#pragma unroll
            for (int i = 0; i < 4; ++i) {
                dk[2 * i] = bflo(k0[i]); dk[2 * i + 1] = bfhi(k0[i]); dk[8 + 2 * i] = bflo(k1[i]); dk[8 + 2 * i + 1] = bfhi(k1[i]);
                dv[2 * i] = bflo(v0[i]); dv[2 * i + 1] = bfhi(v0[i]); dv[8 + 2 * i] = bflo(v1[i]); dv[8 + 2 * i + 1] = bfhi(v1[i]);
            }
        }
        __syncthreads();
        float e0[8], e1[8];
#pragma unroll
        for (int j = 0; j < 8; ++j) {
            const int kk = sub + 8 * j;
            float s0 = 0.f, s1 = 0.f;
#pragma unroll
            for (int d = 0; d < 64; d += 4) {
                const f32x4 q0 = *(const LAS f32x4*)&Qs[qi * 132 + d], k0 = *(const LAS f32x4*)&Ks[kk * 132 + d];
                const f32x4 q1 = *(const LAS f32x4*)&Qs[qi * 132 + 64 + d], k1 = *(const LAS f32x4*)&Ks[kk * 132 + 64 + d];
                s0 += (q0.x * k0.x + q0.y * k0.y) + (q0.z * k0.z + q0.w * k0.w);
                s1 += (q1.x * k1.x + q1.y * k1.y) + (q1.z * k1.z + q1.w * k1.w);
            }
            const int dist = (64 * c + qi) - (64 * kt + kk);
            const float bias = -slope2 * (float)(dist < 0 ? -dist : dist);
            e0[j] = s0 + bias; e1[j] = s1 + bias;
        }
        {
            float tm = e0[0];
#pragma unroll
            for (int j = 1; j < 8; ++j) tm = fmaxf(tm, e0[j]);
            tm = max8lanes(tm);
            const float mn = fmaxf(m0, tm), al = exp2f(m0 - mn);
            float ps = 0.f;
#pragma unroll
            for (int j = 0; j < 8; ++j) { const float p = exp2f(e0[j] - mn); ps += p; Ps[qi * 65 + sub + 8 * j] = p; }
            ps = sum8lanes(ps);
            l0 = l0 * al + ps; m0 = mn;
#pragma unroll
            for (int i = 0; i < 16; ++i) O0[i] *= al;
        }
        {
            float tm = e1[0];
#pragma unroll
            for (int j = 1; j < 8; ++j) tm = fmaxf(tm, e1[j]);
            tm = max8lanes(tm);
            const float mn = fmaxf(m1, tm), al = exp2f(m1 - mn);
            float ps = 0.f;
#pragma unroll
            for (int j = 0; j < 8; ++j) { const float p = exp2f(e1[j] - mn); ps += p; Ps[(64 + qi) * 65 + sub + 8 * j] = p; }
            ps = sum8lanes(ps);
            l1 = l1 * al + ps; m1 = mn;
#pragma unroll
            for (int i = 0; i < 16; ++i) O1[i] *= al;
        }
        __syncthreads();
#pragma unroll 4
        for (int kk = 0; kk < 64; ++kk) {
            const float p0 = Ps[qi * 65 + kk], p1 = Ps[(64 + qi) * 65 + kk];
            const LAS f32x4* vp = (const LAS f32x4*)&Vs[kk * 132 + sub * 16];
#pragma unroll
            for (int q = 0; q < 4; ++q) { const f32x4 v = vp[q];
                O0[4 * q] += p0 * v.x; O0[4 * q + 1] += p0 * v.y; O0[4 * q + 2] += p0 * v.z; O0[4 * q + 3] += p0 * v.w;
                O1[4 * q] += p1 * v.x; O1[4 * q + 1] += p1 * v.y; O1[4 * q + 2] += p1 * v.z; O1[4 * q + 3] += p1 * v.w; }
        }
    }
    const float il0 = 1.0f / l0, il1 = lam / l1;
    float o[16], ss = 0.f;
#pragma unroll
    for (int i = 0; i < 16; ++i) { o[i] = O0[i] * il0 - O1[i] * il1; ss += o[i] * o[i]; }
    ss = sum8lanes(ss);
    const float r = (1.0f / sqrtf(ss * (1.0f / VD) + EPS)) * 0.8f;
    const float* sg = a.in[17] + sub * 16;
    float o8a[8], o8b[8];
#pragma unroll
    for (int i = 0; i < 8; ++i) { o8a[i] = o[i] * r * sg[i]; o8b[i] = o[8 + i] * r * sg[8 + i]; }
    bf16* dst = (bf16*)(F.ws + WS_Y) + ((size_t)b * SEQ + 64 * c + qi) * DM + 512 + h * 128 + sub * 16;
    *(GAS v4u*)dst = pack8(o8a); *(GAS v4u*)(dst + 8) = pack8(o8b);
}
__device__ __forceinline__ float diff_lambda(const Args& a) {
    float s1 = 0.f, s2 = 0.f;
    for (int i = 0; i < HD; ++i) { s1 += a.in[13][i] * a.in[14][i]; s2 += a.in[15][i] * a.in[16][i]; }
    return expf(s1) - expf(s2) + 0.2f;
}
__device__ __forceinline__ void p3_simple(Frame& F, const Args& a) {
    const float lam = diff_lambda(a);
    for (int i = F.vcu; i < BATCH * NH * 32; i += F.G) { const int c = 31 - (i >> 6), bh = i & 63; nattn_unit(F, a, bh >> 2, bh & 3, c, lam); }
    for (int i = F.vcu; i < BATCH * 32; i += F.G) lru_chunk<true>(F, a, i >> 5, i & 31);
}

__device__ __forceinline__ void p4_simple(Frame& F, const Args& a) {
    LAS float* As = (LAS float*)F.lds; LAS float* Bs = As + 64 * 65;
    const bf16* Y = (const bf16*)(F.ws + WS_Y); const bf16* Wout_t = (const bf16*)(F.ws + WS_WOUT);
    const int tid = F.tid, r = tid >> 3, cg = tid & 7;
    for (int tt = F.vcu; tt < (T / 64) * 16; tt += F.G) {
        const int rt = tt >> 4, ct = tt & 15;
        float acc[8] = {0.f, 0.f, 0.f, 0.f, 0.f, 0.f, 0.f, 0.f};
        ngemm_acc(As, Bs, DM, [&](int rr) { return Y + (size_t)(rt * 64 + rr) * DM; }, [&](int cc) { return Wout_t + (size_t)(ct * 64 + cc) * DM; }, acc);
        const size_t off = ((size_t)rt * 64 + r) * DM + ct * 64 + cg * 8;
        const f32x4 x0 = *(const GAS f32x4*)(a.in[0] + off), x1 = *(const GAS f32x4*)(a.in[0] + off + 4);
        *(GAS f32x4*)(F.out + off) = (f32x4){x0.x + acc[0], x0.y + acc[1], x0.z + acc[2], x0.w + acc[3]};
        *(GAS f32x4*)(F.out + off + 4) = (f32x4){x1.x + acc[4], x1.y + acc[5], x1.z + acc[6], x1.w + acc[7]};
    }
}

__device__ __forceinline__ void p5_route(Frame& F, const Args& a) {
    LAS float* Wr = (LAS float*)F.lds;
    __syncthreads();
    for (int i = F.tid; i < 20 * 1024; i += NTHR) {
        const int c = i >> 10, k = i & 1023;
        Wr[i] = (c < 4) ? a.in[20][k * 4 + c] : a.in[22][((size_t)((c - 4) >> 2) * 1024 + k) * 4 + ((c - 4) & 3)];
    }
    __syncthreads();
    const int gw = F.vcu * NWAVES + F.wave, NGW = F.G * NWAVES, lane = F.lane;
    bf16* HN2 = (bf16*)(F.ws + WS_XN); float* gates = (float*)(F.ws + WS_GATES); int* list = (int*)(F.ws + WS_LIST);
    const GAS f32x4* gr = (const GAS f32x4*)a.in[19] + lane;
    for (int m = gw; m < T; m += NGW) {
        const GAS f32x4* xr = (const GAS f32x4*)(F.out + (size_t)m * DM) + lane;
        f32x4 v[4]; float s = 0.f;
#pragma unroll
        for (int j = 0; j < 4; ++j) { v[j] = xr[64 * j]; s += (v[j].x * v[j].x + v[j].y * v[j].y) + (v[j].z * v[j].z + v[j].w * v[j].w); }
        const float r = 1.0f / sqrtf(wave_sum(s) * (1.0f / DM) + EPS);
        GAS v2u* o8 = (GAS v2u*)(HN2 + (size_t)m * DM) + lane;
#pragma unroll
        for (int j = 0; j < 4; ++j) { const f32x4 gg = gr[64 * j]; v[j].x *= r * gg.x; v[j].y *= r * gg.y; v[j].z *= r * gg.z; v[j].w *= r * gg.w;
            v2u w; w.x = pk2(v[j].x, v[j].y); w.y = pk2(v[j].z, v[j].w); o8[64 * j] = w; }
        float lg[20];
#pragma unroll
        for (int c = 0; c < 20; ++c) {
            float acc = 0.f;
#pragma unroll
            for (int j = 0; j < 4; ++j) { const f32x4 w = *(const LAS f32x4*)&Wr[c * 1024 + 256 * j + 4 * lane]; acc += (v[j].x * w.x + v[j].y * w.y) + (v[j].z * w.z + v[j].w * w.w); }
            lg[c] = wave_sum(acc);
            asm volatile("" ::: "memory");
        }
        float gl0 = lg[0] + a.in[21][0], gl1 = lg[1] + a.in[21][1], gl2 = lg[2] + a.in[21][2], gl3 = lg[3] + a.in[21][3];
        int gi = 0; float gm = gl0;
        if (gl1 > gm) { gm = gl1; gi = 1; } if (gl2 > gm) { gm = gl2; gi = 2; } if (gl3 > gm) { gm = gl3; gi = 3; }
        const float pg = 1.0f / (expf(gl0 - gm) + expf(gl1 - gm) + expf(gl2 - gm) + expf(gl3 - gm));
        float el[4];
#pragma unroll
        for (int e = 0; e < 4; ++e) { const float sel = gi == 0 ? lg[4 + e] : gi == 1 ? lg[8 + e] : gi == 2 ? lg[12 + e] : lg[16 + e]; el[e] = sel + a.in[23][gi * 4 + e]; }
        int e1 = 0; float v1 = el[0];
#pragma unroll
        for (int e = 1; e < 4; ++e) if (el[e] > v1) { v1 = el[e]; e1 = e; }
        int e2 = -1; float v2 = -3.0e38f;
#pragma unroll
        for (int e = 0; e < 4; ++e) if (e != e1 && el[e] > v2) { v2 = el[e]; e2 = e; }
        const float w1 = 1.0f / (1.0f + expf(v2 - v1)), w2 = 1.0f - w1;
        const int lo = e1 < e2 ? e1 : e2, hi = e1 < e2 ? e2 : e1;
        const float glo = pg * (e1 < e2 ? w1 : w2), ghi = pg * (e1 < e2 ? w2 : w1);
        const int pi = lo == 0 ? hi - 1 : (lo == 1 ? hi + 1 : 5);
        const int bk = gi * 6 + pi;
        if (lane == 0) {
            const unsigned slot = __hip_atomic_fetch_add((unsigned*)(F.ctl + CW_CNT + bk), 1u, RLX_AGENT);
            list[(size_t)bk * T + slot] = m; gates[2 * (size_t)m] = glo; gates[2 * (size_t)m + 1] = ghi;
            float* gp = (float*)(F.ws + WS_GPOS) + ((size_t)bk * T + slot) * 2; gp[0] = glo; gp[1] = ghi;
        }
    }
}

__device__ __forceinline__ void bucket_tables(Frame& F, LAS int* tb) {
    __syncthreads();
    if (F.tid == 0) {
        int off = 0, pre = 0;
        for (int k = 0; k < NBK; ++k) {
            const int c = (int)__hip_atomic_load((unsigned*)(F.ctl + CW_CNT + k), RLX_AGENT);
            tb[k] = c; tb[24 + k] = off; tb[49 + k] = pre; off += (c + 255) & ~255; pre += (c + 63) >> 6;
        }
        tb[24 + 24] = off; tb[49 + 24] = pre;
    }
    __syncthreads();
}
__device__ __forceinline__ void bk_experts(int bk, int& elo, int& ehi) {
    const int g = bk / 6, pi = bk % 6;
    const int lo = pi < 3 ? 0 : (pi < 5 ? 1 : 2), hi = pi < 3 ? pi + 1 : (pi < 5 ? pi - 1 : 3);
    elo = g * 4 + lo; ehi = g * 4 + hi;
}

__device__ __forceinline__ void p6_simple(Frame& F, const Args& a) {
    LAS float* As = (LAS float*)F.lds; LAS float* Bs = As + 64 * 65; LAS int* tb = (LAS int*)(Bs + 64 * 72);
    bucket_tables(F, tb);
    const bf16* HN2 = (const bf16*)(F.ws + WS_XN); const bf16* Wg_t = (const bf16*)(F.ws + WS_WG); const bf16* Wu_t = (const bf16*)(F.ws + WS_WU);
    const float* gates = (const float*)(F.ws + WS_GATES); const int* list = (const int*)(F.ws + WS_LIST);
    bf16* HID = (bf16*)(F.ws + WS_HID);
    const int tid = F.tid, r = tid >> 3, cg = tid & 7;
    const int ntile = tb[49 + 24];
    for (int u = F.vcu; u < ntile * 16; u += F.G) {
        const int tile = u >> 4, x = (u >> 3) & 1, jt = u & 7;
        int bk = 0;
        for (int k = 1; k < NBK; ++k) if (tile >= tb[49 + k]) bk = k;
        const int rt = tile - tb[49 + bk], cnt = tb[bk], off = tb[24 + bk];
        int elo, ehi; bk_experts(bk, elo, ehi); const int e = x ? ehi : elo;
        const int idx = rt * 64 + r; const bool valid = idx < cnt;
        const int tok = list[(size_t)bk * T + (valid ? idx : 0)];
        const float gate = valid ? gates[2 * (size_t)tok + x] : 0.f;
        float ag[8] = {0.f, 0.f, 0.f, 0.f, 0.f, 0.f, 0.f, 0.f}, au[8] = {0.f, 0.f, 0.f, 0.f, 0.f, 0.f, 0.f, 0.f};
        ngemm_acc(As, Bs, DM, [&](int) { return HN2 + (size_t)tok * DM; }, [&](int cc) { return Wg_t + ((size_t)e * DE + jt * 64 + cc) * DM; }, ag);
        ngemm_acc(As, Bs, DM, [&](int) { return HN2 + (size_t)tok * DM; }, [&](int cc) { return Wu_t + ((size_t)e * DE + jt * 64 + cc) * DM; }, au);
        float hv[8];
#pragma unroll
        for (int j = 0; j < 8; ++j) hv[j] = ag[j] * sigmoidf_(ag[j]) * au[j] * gate;
        *(GAS v4u*)(HID + (size_t)(off + idx) * DM + x * 512 + jt * 64 + cg * 8) = pack8(hv);
    }
}
__device__ __forceinline__ void p7_simple(Frame& F, const Args& a) {
    LAS float* As = (LAS float*)F.lds; LAS float* Bs = As + 64 * 65; LAS int* tb = (LAS int*)(Bs + 64 * 72);
    bucket_tables(F, tb);
    const bf16* HID = (const bf16*)(F.ws + WS_HID); const bf16* Wd_t = (const bf16*)(F.ws + WS_WD);
    const int* list = (const int*)(F.ws + WS_LIST);
    const int tid = F.tid, r = tid >> 3, cg = tid & 7;
    const int ntile = tb[49 + 24];
    for (int u = F.vcu; u < ntile * 16; u += F.G) {
        const int tile = u >> 4, ct = u & 15;
        int bk = 0;
        for (int k = 1; k < NBK; ++k) if (tile >= tb[49 + k]) bk = k;
        const int rt = tile - tb[49 + bk], cnt = tb[bk], off = tb[24 + bk];
        int elo, ehi; bk_experts(bk, elo, ehi);
        const int idx = rt * 64 + r; const bool valid = idx < cnt;
        float acc[8] = {0.f, 0.f, 0.f, 0.f, 0.f, 0.f, 0.f, 0.f};
        ngemm_acc(As, Bs, DE, [&](int rr) { return HID + (size_t)(off + rt * 64 + rr) * DM; }, [&](int cc) { return Wd_t + ((size_t)elo * DM + ct * 64 + cc) * DE; }, acc);
        ngemm_acc(As, Bs, DE, [&](int rr) { return HID + (size_t)(off + rt * 64 + rr) * DM + 512; }, [&](int cc) { return Wd_t + ((size_t)ehi * DM + ct * 64 + cc) * DE; }, acc);
        if (valid) {
            const int tok = list[(size_t)bk * T + idx];
            const size_t o = (size_t)tok * DM + ct * 64 + cg * 8;
            const f32x4 h0 = *(const GAS f32x4*)(F.out + o), h1 = *(const GAS f32x4*)(F.out + o + 4);
            *(GAS f32x4*)(F.out + o) = (f32x4){h0.x + acc[0], h0.y + acc[1], h0.z + acc[2], h0.w + acc[3]};
            *(GAS f32x4*)(F.out + o + 4) = (f32x4){h1.x + acc[4], h1.y + acc[5], h1.z + acc[6], h1.w + acc[7]};
        }
    }
}


struct EpiOutRes {
    const float* x; float* out;
    __device__ __forceinline__ void operator()(const f32x4 (&acc)[2][2][4][2], const pg8::GUnit& u, int wr, int wc, int fr, int fq) const {
        const size_t row0 = (size_t)u.pm * 256 + wr * 64 + fr; const int col0 = u.pn * 256 + wc * 32 + 4 * fq;
#pragma unroll
        for (int ai = 0; ai < 2; ++ai)
#pragma unroll
            for (int m = 0; m < 4; ++m) { const size_t off = (row0 + ai * 128 + m * 16) * DM + col0;
#pragma unroll
                for (int bj = 0; bj < 2; ++bj)
#pragma unroll
                    for (int n = 0; n < 2; ++n) { const f32x4 xv = *(const GAS f32x4*)(x + off + bj * 128 + n * 16); *(GAS f32x4*)(out + off + bj * 128 + n * 16) = xv + acc[ai][bj][m][n]; }
                if (m & 1) asm volatile("" ::: "memory"); }
    }
};
__device__ __forceinline__ void p4_fast(Frame& F, const Args& a) {
    pg8::GemmCfg g; g.nt = DM / 64; g.kseg = g.nt; g.lda = DM * 2; g.ldb = DM * 2; g.hstepA = (size_t)128 * DM * 2; g.hstepB = (size_t)128 * DM * 2; g.bmap = pg8::MAP_NAT; g.glist = nullptr;
    pg8::TileOrder S; S.nM = T / 256; S.nN = DM / 256; S.G = F.G; S.c = F.vcu; S.A = (const char*)(F.ws + WS_Y); S.B = (const char*)(F.ws + WS_WOUT); S.tstepA = (size_t)256 * DM * 2; S.tstepB = (size_t)256 * DM * 2;
    EpiOutRes E; E.x = a.in[0]; E.out = F.out;
    pg8::gemm_phase<EpiOutRes, pg8::TileOrder, false, false>(F.lds, g, S, E);
}

constexpr int TB_OFF = 131072, TB_PRE = 24, TB_R6 = 64, TB_R7 = 384;
__device__ __forceinline__ void moe_tables(Frame& F) {
    LAS int* tb = (LAS int*)(F.lds + TB_OFF);
    __syncthreads();
    if (F.tid == 0) {
        int pre = 0;
        for (int k = 0; k < NBK; ++k) { const int c = (int)__hip_atomic_load((unsigned*)(F.ctl + CW_CNT + k), RLX_AGENT); tb[k] = c; tb[TB_PRE + k] = pre; pre += (c + 255) >> 8; }
        tb[TB_PRE + 24] = pre;
    }
    __syncthreads();
    const int np = tb[TB_PRE + 24];
    for (int q = F.tid; q < 2 * np; q += NTHR) {
        int bk = 0;
        for (int k = 1; k < NBK; ++k) if (q >= 2 * tb[TB_PRE + k]) bk = k;
        const int ntk = tb[TB_PRE + bk + 1] - tb[TB_PRE + bk]; const int r = q - 2 * tb[TB_PRE + bk]; const int x = r >= ntk ? 1 : 0; const int rt = r - x * ntk;
        tb[TB_R6 + q] = bk | (x << 8) | (rt << 16);
    }
    for (int q = F.tid; q < np; q += NTHR) {
        int bk = 0;
        for (int k = 1; k < NBK; ++k) if (q >= tb[TB_PRE + k]) bk = k;
        tb[TB_R7 + q] = bk | ((q - tb[TB_PRE + bk]) << 16);
    }
    __syncthreads();
}
struct MoeUpOrder {
    const LAS int* tb; int G, c; const char* hn2; const char* wg;
    __device__ __forceinline__ bool next(int i, pg8::GUnit& u) const {
        const int L = i * G + c; const int nq = 2 * tb[TB_PRE + 24]; if (L >= 4 * nq) return false;
        const int q = L >> 2, pn = L & 3; const int w = tb[TB_R6 + q]; const int bk = w & 255, x = (w >> 8) & 1, rt = w >> 16;
        int elo, ehi; bk_experts(bk, elo, ehi); const int e = x ? ehi : elo;
        u.A = hn2; u.B = wg + ((size_t)e * DE + pn * 128) * (DM * 2); u.B2 = nullptr;
        u.pm = bk * T; u.e0 = rt * 256; u.e1 = tb[bk] - rt * 256; u.pn = pn | (x << 8) | ((tb[TB_PRE + bk] + rt) << 16);
        return true;
    }
};
struct EpiGateUp {
    bf16* hid; const float* gpos;
    __device__ __forceinline__ void operator()(const f32x4 (&acc)[2][2][4][2], const pg8::GUnit& u, int wr, int wc, int fr, int fq) const {
        const int pn = u.pn & 255, x = (u.pn >> 8) & 1, trow = u.pn >> 16;
        const int col0 = x * 512 + pn * 128 + 32 * wc + 8 * fq;
#pragma unroll
        for (int ai = 0; ai < 2; ++ai)
#pragma unroll
            for (int m = 0; m < 4; ++m) {
                const int it = ai * 128 + wr * 64 + m * 16 + fr; const bool valid = it < u.e1;
                const float gate = valid ? gpos[((size_t)u.pm + u.e0 + it) * 2 + x] : 0.f;
                float hv[8];
#pragma unroll
                for (int n = 0; n < 2; ++n) { const f32x4 gv = acc[ai][0][m][n], uv = acc[ai][1][m][n];
                    hv[4 * n + 0] = gv.x * sigmoidf_(gv.x) * uv.x * gate; hv[4 * n + 1] = gv.y * sigmoidf_(gv.y) * uv.y * gate;
                    hv[4 * n + 2] = gv.z * sigmoidf_(gv.z) * uv.z * gate; hv[4 * n + 3] = gv.w * sigmoidf_(gv.w) * uv.w * gate; }
                v4u w; w.x = pg8::cvt_pk_bf16(hv[0], hv[1]); w.y = pg8::cvt_pk_bf16(hv[2], hv[3]); w.z = pg8::cvt_pk_bf16(hv[4], hv[5]); w.w = pg8::cvt_pk_bf16(hv[6], hv[7]);
                *(GAS v4u*)(hid + ((size_t)trow * 256 + it) * DM + col0) = w;
            }
    }
};
__device__ __forceinline__ void p6_fast(Frame& F, const Args& a) {
    moe_tables(F);
    pg8::GemmCfg g; g.nt = DM / 64; g.kseg = g.nt; g.lda = DM * 2; g.ldb = DM * 2; g.hstepA = 0; g.hstepB = (size_t)(WS_WU - WS_WG); g.bmap = pg8::MAP_P32; g.glist = (const int*)(F.ws + WS_LIST);
    MoeUpOrder S; S.tb = (const LAS int*)(F.lds + TB_OFF); S.G = F.G; S.c = F.vcu; S.hn2 = (const char*)(F.ws + WS_XN); S.wg = (const char*)(F.ws + WS_WG);
    EpiGateUp E; E.hid = (bf16*)(F.ws + WS_HID); E.gpos = (const float*)(F.ws + WS_GPOS);
    pg8::gemm_phase<EpiGateUp, MoeUpOrder, true, false>(F.lds, g, S, E);
}
struct MoeDownOrder {
    const LAS int* tb; int G, c; const char* hid; const char* wd;
    __device__ __forceinline__ bool next(int i, pg8::GUnit& u) const {
        const int L = i * G + c; const int nM = tb[TB_PRE + 24]; if (L >= 4 * nM) return false;
        const int nig = 32, gid = L / nig, fm = gid * 8, gsz = (nM - fm) < 8 ? (nM - fm) : 8;
        const int q = fm + ((L % nig) % gsz), pn = (L % nig) / gsz;
        const int w = tb[TB_R7 + q]; const int bk = w & 255, rt = w >> 16;
        int elo, ehi; bk_experts(bk, elo, ehi);
        u.A = hid + (size_t)q * 256 * (DM * 2); u.B = wd + ((size_t)elo * DM + pn * 256) * (DE * 2); u.B2 = wd + ((size_t)ehi * DM + pn * 256) * (DE * 2);
        u.pm = bk * T; u.e0 = rt * 256; u.e1 = tb[bk] - rt * 256; u.pn = pn;
        return true;
    }
};
struct EpiDown {
    float* out; const int* list;
    __device__ __forceinline__ void operator()(const f32x4 (&acc)[2][2][4][2], const pg8::GUnit& u, int wr, int wc, int fr, int fq) const {
        const int col0 = u.pn * 256 + wc * 32 + 4 * fq;
#pragma unroll
        for (int ai = 0; ai < 2; ++ai)
#pragma unroll
            for (int m = 0; m < 4; ++m) {
                const int it = ai * 128 + wr * 64 + m * 16 + fr;
                if (it < u.e1) {
                    const int tok = list[u.pm + u.e0 + it]; float* rowp = out + (size_t)tok * DM + col0;
#pragma unroll
                    for (int bj = 0; bj < 2; ++bj)
#pragma unroll
                        for (int n = 0; n < 2; ++n) { const f32x4 hv = *(const GAS f32x4*)(rowp + bj * 128 + n * 16); *(GAS f32x4*)(rowp + bj * 128 + n * 16) = hv + acc[ai][bj][m][n]; }
                }
                if (m & 1) asm volatile("" ::: "memory");
            }
    }
};
__device__ __forceinline__ void p7_fast(Frame& F, const Args& a) {
    moe_tables(F);
    pg8::GemmCfg g; g.nt = DM / 64; g.kseg = 8; g.lda = DM * 2; g.ldb = DE * 2; g.hstepA = (size_t)128 * DM * 2; g.hstepB = (size_t)128 * DE * 2; g.bmap = pg8::MAP_NAT; g.glist = nullptr;
    MoeDownOrder S; S.tb = (const LAS int*)(F.lds + TB_OFF); S.G = F.G; S.c = F.vcu; S.hid = (const char*)(F.ws + WS_HID); S.wd = (const char*)(F.ws + WS_WD);
    EpiDown E; E.out = F.out; E.list = (const int*)(F.ws + WS_LIST);
    pg8::gemm_phase<EpiDown, MoeDownOrder, false, true>(F.lds, g, S, E);
}

__global__ void __launch_bounds__(NTHR, 2) fwd_kernel(Args args) {
    extern __shared__ __attribute__((aligned(16))) unsigned char lds[];
    Frame F;
    F.lds = (LAS unsigned char*)lds;
    F.MISC = (volatile LAS unsigned*)(F.lds + MISC_OFF);
    F.tid = threadIdx.x; F.lane = F.tid & 63; F.wave = __builtin_amdgcn_readfirstlane(F.tid >> 6);
    F.G = gridDim.x; { const int bx = blockIdx.x; F.vcu = (F.G % 8 == 0) ? (bx % 8) * (F.G / 8) + bx / 8 : bx; }
    F.ws = args.ws; F.out = args.out; F.ctl = (gu32*)(args.ws + WS_CTL);
    for (int u = F.tid; u < (LDS_BYTES - LDSCTL_OFF) / 4; u += NTHR) ((LAS unsigned*)(F.lds + LDSCTL_OFF))[u] = 0u;
    __syncthreads();
    XcdBarrier bar; bar.bar = (unsigned*)(F.ctl + CW_BAR); bar.x = 0; bar.st = nullptr;
    if (N_LAUNCHES != PER_PHASE) bar = xcd_barrier_post((unsigned*)(F.ctl + CW_BAR), F.MISC + 8);
#define GRID_BAR() do { if (N_LAUNCHES != PER_PHASE) xcd_barrier(bar); } while (0)
    const int lo = args.ph_lo, hi = args.ph_hi;
#define IN(k) (lo <= (k) && (k) < hi)
#define BOTH(k) (IN(k) && IN((k) + 1))
    if (IN(0)) { p0_prologue(F, args); if (BOTH(0)) GRID_BAR(); }
    if (IN(1)) { p1_fast(F, args); if (BOTH(1)) GRID_BAR(); }
    if (IN(2)) { for (int i = F.vcu; i < BATCH * 32; i += F.G) lru_chunk<false>(F, args, i >> 5, i & 31); if (BOTH(2)) GRID_BAR(); }
    if (IN(3)) { p3_simple(F, args); if (BOTH(3)) GRID_BAR(); }
    if (IN(4)) { p4_fast(F, args); if (BOTH(4)) GRID_BAR(); }
    if (IN(5)) { p5_route(F, args); if (BOTH(5)) GRID_BAR(); }
    if (IN(6)) { p6_fast(F, args); if (BOTH(6)) GRID_BAR(); }
    if (IN(7)) { p7_fast(F, args); }
#undef IN
#undef BOTH
}

extern "C" void kernel_launch(void* const* d_in, const int* in_sizes, int n_in, void* d_out, int out_size, void* d_ws, size_t ws_size, hipStream_t stream) {
    static int grid = 0;
    if (grid == 0) {
        if (n_in != 27 || in_sizes[0] != T * DM || out_size != T * DM || ws_size < WS_END) {
            fprintf(stderr, "kernel_launch: unexpected shapes (n_in %d, in0 %d, out %d, ws %zu); nothing launched\n", n_in, n_in > 0 ? in_sizes[0] : -1, out_size, ws_size); grid = -1; return; }
        int dev = 0, cus = 0;
        if (hipGetDevice(&dev) != hipSuccess || hipDeviceGetAttribute(&cus, hipDeviceAttributeMultiprocessorCount, dev) != hipSuccess) { grid = -1; return; }
        if (hipFuncSetAttribute((const void*)fwd_kernel, hipFuncAttributeMaxDynamicSharedMemorySize, LDS_BYTES) != hipSuccess) { fprintf(stderr, "kernel_launch: hipFuncSetAttribute failed\n"); grid = -1; return; }
        (void)hipGetLastError();
        grid = cus;
    }
    if (grid < 0) return;
    if (hipMemsetAsync((char*)d_ws + WS_CTL, 0, CTL_ZERO_BYTES, stream) != hipSuccess) return;
    Args a{};
    for (int i = 0; i < 27; ++i) a.in[i] = (const float*)d_in[i];
    a.out = (float*)d_out; a.ws = (unsigned char*)d_ws;
    for (int li = 0; li < N_LAUNCHES; ++li) {
        a.ph_lo = (N_LAUNCHES == PER_PHASE) ? li : 0; a.ph_hi = (N_LAUNCHES == PER_PHASE) ? li + 1 : PER_PHASE; a.li = li;
        hipLaunchKernelGGL(fwd_kernel, dim3(grid), dim3(NTHR), LDS_BYTES, stream, a);
    }
}
```

```cpp
#include <hip/hip_runtime.h>
#include <cstdio>
#include <cstdint>

#ifndef MK_N_LAUNCHES
#define MK_N_LAUNCHES 1
#endif
constexpr int N_LAUNCHES = MK_N_LAUNCHES;
constexpr int PER_PHASE = 8;

#define GAS __attribute__((address_space(1)))
#define LAS __attribute__((address_space(3)))
typedef unsigned short bf16;
typedef unsigned v4u __attribute__((ext_vector_type(4)));
typedef unsigned v2u __attribute__((ext_vector_type(2)));
typedef float f32x4 __attribute__((ext_vector_type(4)));
typedef GAS unsigned gu32;
#define RLX_AGENT __ATOMIC_RELAXED, __HIP_MEMORY_SCOPE_AGENT
#define LDS_WAIT() asm volatile("s_waitcnt lgkmcnt(0)" ::: "memory")
#define VM_WAIT() asm volatile("s_waitcnt vmcnt(0)" ::: "memory")

constexpr int BATCH = 16, SEQ = 2048, DM = 1024, T = BATCH * SEQ;
constexpr int LW = 512, AW = 512, NH = 4, HD = 64, VD = 128, INC = 2560;
constexpr int NE = 16, DE = 512, NBK = 24;
constexpr float EPS = 1e-6f;
constexpr float LOG2E = 1.4426950408889634f;
constexpr float C2 = 0.125f * LOG2E;
constexpr int NWAVES = 8, NTHR = 512;

constexpr size_t MiB = 1u << 20;
constexpr size_t WS_CTL = 0, CTL_ZERO_BYTES = 1 * MiB;
constexpr size_t WS_WIN = 2 * MiB;
constexpr size_t WS_WOUT = 8 * MiB;
constexpr size_t WS_WG = 10 * MiB;
constexpr size_t WS_WU = 26 * MiB;
constexpr size_t WS_WD = 42 * MiB;
constexpr size_t WS_AGG = 58 * MiB;
constexpr size_t WS_GATES = 60 * MiB;
constexpr size_t WS_LIST = 61 * MiB;
constexpr size_t WS_XN = 64 * MiB;
constexpr size_t WS_XL = 128 * MiB;
constexpr size_t WS_GL = 160 * MiB;
constexpr size_t WS_Q = 192 * MiB;
constexpr size_t WS_K = 224 * MiB;
constexpr size_t WS_V = 256 * MiB;
constexpr size_t WS_Y = 288 * MiB;
constexpr size_t WS_HID = 128 * MiB;
constexpr int HID_ROWS = T + NBK * 256;
constexpr size_t WS_GPOS = 352 * MiB;
constexpr size_t WS_END = 360 * MiB;
static_assert(WS_HID + (size_t)HID_ROWS * 2048 <= WS_K, "hid overlay");
constexpr int CW_TMO = 0, CW_BAR = 4096, CW_CNT = 8192;

constexpr int SCR_BYTES = 143360;
constexpr int LDSCTL_OFF = SCR_BYTES, MISC_OFF = LDSCTL_OFF + 320;
constexpr int LDS_BYTES = 147456;

__device__ __forceinline__ unsigned f2bf(float f) { unsigned u = __builtin_bit_cast(unsigned, f); return (u + 0x7fffu + ((u >> 16) & 1u)) >> 16; }
__device__ __forceinline__ unsigned pk2(float lo, float hi) { return f2bf(lo) | (f2bf(hi) << 16); }
__device__ __forceinline__ float bf2f(bf16 b) { return __builtin_bit_cast(float, (unsigned)b << 16); }
__device__ __forceinline__ float bflo(unsigned w) { return __builtin_bit_cast(float, w << 16); }
__device__ __forceinline__ float bfhi(unsigned w) { return __builtin_bit_cast(float, w & 0xffff0000u); }
__device__ __forceinline__ float wave_sum(float v) {
#pragma unroll
    for (int o = 1; o < 64; o <<= 1) v += __shfl_xor(v, o);
    return v;
}
__device__ __forceinline__ int opaque_tid() { int t = threadIdx.x; asm volatile("" : "+v"(t)); return t; }
__device__ __forceinline__ float sigmoidf_(float x) { return 1.0f / (1.0f + __expf(-x)); }
__device__ __forceinline__ float gelu_tanh(float x) {
    const float z = 0.7978845608028654f * (x + 0.044715f * x * x * x);
    const float e = __expf(2.0f * z);
    const float th = 1.0f - 2.0f / (e + 1.0f);
    return 0.5f * x * (1.0f + th);
}

#define XB_TMO      128
#define XB_XCNT(j)  (256  + 64 * (j))
#define XB_XSUB(j)  (1280 + 64 * (j))
#define XB_XGEN(j)  (2304 + 64 * (j))
#define XB_TOP      3328
#define XB_TOPGEN   3392
#define XCD_BAR_WORDS 3456
#define XB_SPIN_CAP (1u << 18)
__device__ __forceinline__ unsigned xb_ld(unsigned* p)              { return __hip_atomic_load(p, __ATOMIC_RELAXED, __HIP_MEMORY_SCOPE_AGENT); }
__device__ __forceinline__ unsigned xb_add(unsigned* p, unsigned v) { return __hip_atomic_fetch_add(p, v, __ATOMIC_RELAXED, __HIP_MEMORY_SCOPE_AGENT); }
__device__ __forceinline__ unsigned xb_xcc_id() { return (unsigned)__builtin_amdgcn_s_getreg((3 << 11) | 20) & 0xFu; }
#define XB_SPIN(cond, bar) do { unsigned _sp = 0; while (cond) { __builtin_amdgcn_s_sleep(1); \
    if ((++_sp & 255u) == 0u) { if (xb_ld(&(bar)[XB_TMO])) break; if (_sp > XB_SPIN_CAP) { atomicAdd(&(bar)[XB_TMO], 1u); break; } } } } while (0)
struct XcdBarrier { unsigned* bar; unsigned x; volatile LAS unsigned* st; };
__device__ __forceinline__ XcdBarrier xcd_barrier_post(unsigned* bar, volatile LAS unsigned* st) {
    XcdBarrier b; b.bar = bar; b.x = xb_xcc_id(); b.st = st;
    if (threadIdx.x == 0) (void)xb_add(&bar[XB_XCNT(b.x)], 1u);
    return b;
}
__device__ __forceinline__ void xcd_barrier_complete(unsigned* bar, unsigned x, unsigned& nloc, unsigned& nx) {
    const unsigned G = gridDim.x * gridDim.y * gridDim.z;
    unsigned sum, cnt, mine, sp = 0u;
    for (;;) {
        sum = 0u; cnt = 0u; mine = 0u;
#pragma unroll
        for (unsigned j = 0; j < 16; ++j) { const unsigned c = xb_ld(&bar[XB_XCNT(j)]); sum += c; cnt += (c > 0u) ? 1u : 0u; mine = (j == x) ? c : mine; }
        if (sum == G) break;
        __builtin_amdgcn_s_sleep(1);
        if ((++sp & 255u) == 0u) { if (xb_ld(&bar[XB_TMO])) break; if (sp > XB_SPIN_CAP) { atomicAdd(&bar[XB_TMO], 1u); break; } }
    }
    nloc = mine > 0u ? mine : 1u; nx = cnt > 0u ? cnt : 1u;
}
__device__ __forceinline__ void xcd_barrier(const XcdBarrier& b) {
    asm volatile("s_waitcnt vmcnt(0)" ::: "memory");
    __syncthreads();
    if (threadIdx.x == 0) {
        unsigned* bar = b.bar;
        __builtin_amdgcn_s_waitcnt(0);
        unsigned nloc = b.st[0], nx = b.st[1];
        if (nloc == 0u) { xcd_barrier_complete(bar, b.x, nloc, nx); b.st[0] = nloc; b.st[1] = nx; }
        const unsigned old = xb_add(&bar[XB_XSUB(b.x)], 1u);
        const unsigned gen = old / nloc;
        if (old + 1u == (gen + 1u) * nloc) {
            __builtin_amdgcn_fence(__ATOMIC_RELEASE, "agent");
            asm volatile("s_waitcnt vmcnt(0)" ::: "memory");
            const unsigned og = xb_add(&bar[XB_TOP], 1u);
            const unsigned tg = og / nx;
            if (og + 1u == (tg + 1u) * nx) xb_add(&bar[XB_TOPGEN], 1u);
            else XB_SPIN(xb_ld(&bar[XB_TOPGEN]) == tg, bar);
            __builtin_amdgcn_fence(__ATOMIC_ACQUIRE, "agent");
            xb_add(&bar[XB_XGEN(b.x)], 1u);
            asm volatile("s_waitcnt vmcnt(0)" ::: "memory");
        } else {
            XB_SPIN(xb_ld(&bar[XB_XGEN(b.x)]) == gen, bar);
            __builtin_amdgcn_fence(__ATOMIC_ACQUIRE, "agent");
            asm volatile("s_waitcnt vmcnt(0)" ::: "memory");
        }
    }
    __syncthreads();
}

struct Args { const float* in[27]; float* out; unsigned char* ws; int ph_lo, ph_hi, li, pad; };
struct Frame {
    LAS unsigned char* lds; volatile LAS unsigned* MISC; gu32* ctl;
    int tid, lane, wave, vcu, G;
    unsigned char* ws; float* out;
    __device__ __forceinline__ void retid() { tid = opaque_tid(); lane = tid & 63; wave = __builtin_amdgcn_readfirstlane(tid >> 6); }
};

__device__ __forceinline__ void p0_transpose_item(const float* W, int K, int N, bf16* WT, LAS float* scr, int item, int lane) {
    const int nblk = N / 32, kb = item / nblk, nb = item % nblk, k0 = 64 * kb, n0 = 32 * nb;
#pragma unroll 8
    for (int i = 0; i < 32; ++i) { const int kk = 2 * i + (lane >> 5); scr[kk * 33 + (lane & 31)] = W[(size_t)(k0 + kk) * N + n0 + (lane & 31)]; }
    LDS_WAIT(); asm volatile("" ::: "memory");
    const int c = lane & 7;
#pragma unroll
    for (int j = 0; j < 4; ++j) { const int n = (lane >> 3) + 8 * j; const LAS float* s = scr + (8 * c) * 33 + n;
        v4u o; o.x = pk2(s[0 * 33], s[1 * 33]); o.y = pk2(s[2 * 33], s[3 * 33]); o.z = pk2(s[4 * 33], s[5 * 33]); o.w = pk2(s[6 * 33], s[7 * 33]);
        *(GAS v4u*)(WT + (size_t)(n0 + n) * K + k0 + 8 * c) = o; }
    LDS_WAIT(); asm volatile("" ::: "memory");
}
__device__ __forceinline__ void rms_row_to_bf16(const float* xrow, const float* g, bf16* orow, int lane) {
    const GAS f32x4* xr = (const GAS f32x4*)xrow + lane;
    const GAS f32x4* gr = (const GAS f32x4*)g + lane;
    f32x4 v[4]; float s = 0.f;
#pragma unroll
    for (int j = 0; j < 4; ++j) { v[j] = xr[64 * j]; s += (v[j].x * v[j].x + v[j].y * v[j].y) + (v[j].z * v[j].z + v[j].w * v[j].w); }
    const float r = 1.0f / sqrtf(wave_sum(s) * (1.0f / DM) + EPS);
    GAS v2u* o8 = (GAS v2u*)orow + lane;
#pragma unroll
    for (int j = 0; j < 4; ++j) { const f32x4 gg = gr[64 * j]; v2u w; w.x = pk2(v[j].x * r * gg.x, v[j].y * r * gg.y); w.y = pk2(v[j].z * r * gg.z, v[j].w * r * gg.w); o8[64 * j] = w; }
}
__device__ __forceinline__ void p0_prologue(Frame& F, const Args& a) {
    LAS float* scr = (LAS float*)(F.lds + F.wave * 16384);
    const int gw = F.vcu * NWAVES + F.wave, NGW = F.G * NWAVES;
    constexpr int I_IN = (DM / 64) * (INC / 32), I_OUT = (DM / 64) * (DM / 32), I_E = 256;
    constexpr int NITEMS = I_IN + I_OUT + 3 * NE * I_E;
    bf16* Win_t = (bf16*)(F.ws + WS_WIN); bf16* Wout_t = (bf16*)(F.ws + WS_WOUT);
    bf16* Wg_t = (bf16*)(F.ws + WS_WG); bf16* Wu_t = (bf16*)(F.ws + WS_WU); bf16* Wd_t = (bf16*)(F.ws + WS_WD);
    for (int it = gw; it < NITEMS; it += NGW) {
        int r = it;
        if (r < I_IN) { p0_transpose_item(a.in[2], DM, INC, Win_t, scr, r, F.lane); continue; } r -= I_IN;
        if (r < I_OUT) { p0_transpose_item(a.in[18], DM, DM, Wout_t, scr, r, F.lane); continue; } r -= I_OUT;
        if (r < NE * I_E) { const int e = r / I_E; p0_transpose_item(a.in[24] + (size_t)e * DM * DE, DM, DE, Wg_t + (size_t)e * DE * DM, scr, r % I_E, F.lane); continue; } r -= NE * I_E;
        if (r < NE * I_E) { const int e = r / I_E; p0_transpose_item(a.in[25] + (size_t)e * DM * DE, DM, DE, Wu_t + (size_t)e * DE * DM, scr, r % I_E, F.lane); continue; } r -= NE * I_E;
        { const int e = r / I_E; p0_transpose_item(a.in[26] + (size_t)e * DE * DM, DE, DM, Wd_t + (size_t)e * DM * DE, scr, r % I_E, F.lane); }
    }
    bf16* XN = (bf16*)(F.ws + WS_XN);
    for (int m = gw; m < T; m += NGW) rms_row_to_bf16(a.in[0] + (size_t)m * DM, a.in[1], XN + (size_t)m * DM, F.lane);
}

template <class AF, class BF>
__device__ __forceinline__ void ngemm_acc(LAS float* As, LAS float* Bs, int K, AF arow, BF bcol, float (&acc)[8]) {
    const int tid = threadIdx.x, r = tid >> 3, cg = tid & 7;
    const bf16* ap = arow(r); const bf16* bp = bcol(r);
    for (int k0 = 0; k0 < K; k0 += 64) {
        __syncthreads();
        const v4u va = *(const GAS v4u*)(ap + k0 + cg * 8);
        const v4u vb = *(const GAS v4u*)(bp + k0 + cg * 8);
#pragma unroll
        for (int j = 0; j < 4; ++j) {
            As[r * 65 + cg * 8 + 2 * j] = bflo(va[j]); As[r * 65 + cg * 8 + 2 * j + 1] = bfhi(va[j]);
            Bs[(cg * 8 + 2 * j) * 72 + r] = bflo(vb[j]); Bs[(cg * 8 + 2 * j + 1) * 72 + r] = bfhi(vb[j]);
        }
        __syncthreads();
#pragma unroll 8
        for (int kk = 0; kk < 64; ++kk) {
            const float av = As[r * 65 + kk];
            const f32x4 b0 = *(const LAS f32x4*)&Bs[kk * 72 + cg * 8], b1 = *(const LAS f32x4*)&Bs[kk * 72 + cg * 8 + 4];
            acc[0] += av * b0.x; acc[1] += av * b0.y; acc[2] += av * b0.z; acc[3] += av * b0.w;
            acc[4] += av * b1.x; acc[5] += av * b1.y; acc[6] += av * b1.z; acc[7] += av * b1.w;
        }
    }
}
__device__ __forceinline__ v4u pack8(const float (&v)[8]) { v4u o; o.x = pk2(v[0], v[1]); o.y = pk2(v[2], v[3]); o.z = pk2(v[4], v[5]); o.w = pk2(v[6], v[7]); return o; }
__device__ __forceinline__ float sum8lanes(float v) { v += __shfl_xor(v, 1); v += __shfl_xor(v, 2); v += __shfl_xor(v, 4); return v; }
__device__ __forceinline__ float max8lanes(float v) { v = fmaxf(v, __shfl_xor(v, 1)); v = fmaxf(v, __shfl_xor(v, 2)); v = fmaxf(v, __shfl_xor(v, 4)); return v; }

__device__ __forceinline__ void p1_simple(Frame& F, const Args& a) {
    LAS float* As = (LAS float*)F.lds; LAS float* Bs = As + 64 * 65;
    const bf16* XN = (const bf16*)(F.ws + WS_XN); const bf16* Win_t = (const bf16*)(F.ws + WS_WIN);
    const int tid = F.tid, r = tid >> 3, cg = tid & 7;
    constexpr int NCT = INC / 64;
    for (int tt = F.vcu; tt < (T / 64) * NCT; tt += F.G) {
        const int rt = tt / NCT, ct = tt % NCT;
        float acc[8] = {0.f, 0.f, 0.f, 0.f, 0.f, 0.f, 0.f, 0.f};
        ngemm_acc(As, Bs, DM, [&](int rr) { return XN + (size_t)(rt * 64 + rr) * DM; }, [&](int cc) { return Win_t + (size_t)(ct * 64 + cc) * DM; }, acc);
        const int region = ct >> 3, lc0 = (ct & 7) * 64 + cg * 8; const size_t row = (size_t)rt * 64 + r;
        bf16* dst = (bf16*)(F.ws + WS_XL + (size_t)region * 32 * MiB) + row * 512 + lc0;
        if (region == 1) {
#pragma unroll
            for (int j = 0; j < 8; ++j) acc[j] = gelu_tanh(acc[j]);
        } else if (region == 2 || region == 3) {
            float ss = 0.f;
#pragma unroll
            for (int j = 0; j < 8; ++j) ss += acc[j] * acc[j];
            ss = sum8lanes(ss);
            const float rr = (1.0f / sqrtf(ss * (1.0f / HD) + EPS)) * (region == 2 ? C2 : 1.0f);
            const float* g = a.in[region == 2 ? 11 : 12] + cg * 8;
#pragma unroll
            for (int j = 0; j < 8; ++j) acc[j] = acc[j] * rr * g[j];
        }
        *(GAS v4u*)dst = pack8(acc);
    }
}


namespace pg8 {
typedef short bf16x8 __attribute__((ext_vector_type(8)));
constexpr int BM = 256, BK = 64, HALF = 128, HTB = HALF * BK * 2, STAGE_BYTES = 8 * HTB;
__host__ __device__ __forceinline__ int lds_byte(int r, int c) { const int st = (r >> 4) * 2 + (c >> 5), rr = r & 15, cc = c & 31, ob = rr * 64 + cc * 2; return st * 1024 + (ob ^ (((ob >> 9) & 1) << 5)); }
__host__ __device__ __forceinline__ void stage_rc(int b, int& R, int& C) { const int st = b / 1024, sb = b % 1024, swz = sb ^ (((sb >> 9) & 1) << 5); R = (st >> 1) * 16 + swz / 64; C = (st & 1) * 32 + (swz % 64) / 2; }
__host__ __device__ __forceinline__ int perm32(int rho) { const int n = rho >> 4, i = rho & 15; return 8 * (i >> 2) + 4 * n + (i & 3); }
enum { MAP_NAT = 0, MAP_P32 = 1, MAP_G64 = 2 };
__device__ __forceinline__ int bmap_row(int map, int R) { return map == MAP_NAT ? R : (map == MAP_P32 ? 32 * (R >> 5) + perm32(R & 31) : 64 * (R >> 5) + perm32(R & 31)); }

struct GUnit { const char* A; const char* B; const char* B2; int pm, pn, e0, e1; };

struct GemmCfg { int nt, kseg; unsigned lda, ldb; size_t hstepA, hstepB; int bmap; const int* glist; };

template <class Epi, class Sched, bool GATHER, bool SEGB>
__device__ __forceinline__ void gemm_phase(LAS unsigned char* lds, const GemmCfg g, const Sched& S, const Epi& E) {
    const int tid = opaque_tid(), wid = __builtin_amdgcn_readfirstlane(tid >> 6), lane = tid & 63, wr = wid >> 2, wc = wid & 3, fr = lane & 15, fq = lane >> 4;
    const int nt = g.nt;
    unsigned voffA[2], voffB[2]; int RA[2];
#pragma unroll
    for (int i = 0; i < 2; ++i) { int R, C; stage_rc(tid * 16 + i * 8192, R, C); RA[i] = R;
        voffA[i] = GATHER ? (unsigned)(C * 2) : (unsigned)R * g.lda + (unsigned)(C * 2); voffB[i] = (unsigned)bmap_row(g.bmap, R) * g.ldb + (unsigned)(C * 2); }
    const size_t kstep = (size_t)(BK * 2);
    const size_t hstepA = g.hstepA, hstepB = g.hstepB;
    const unsigned ldsw = (unsigned)wid * 1024u;
    const int aoff = lds_byte(wr * 64 + fr, fq * 8), boff = lds_byte(wc * 32 + fr, fq * 8);
#define PG8_SA(b, h) (((b) * 2 + (h)) * HTB)
#define PG8_SB(b, h) ((4 + (b) * 2 + (h)) * HTB)
#define PG8_STAGE(bufoff, gbase, voff) do { _Pragma("unroll") for (int _i = 0; _i < 2; ++_i) \
        __builtin_amdgcn_global_load_lds((const unsigned*)((const char*)(gbase) + (voff)[_i]), (LAS unsigned*)(lds + (bufoff) + ldsw + _i * 8192), 16, 0, 0); } while (0)
#define PG8_LDA(dst, b, h) do { _Pragma("unroll") for (int m = 0; m < 4; ++m) _Pragma("unroll") for (int k = 0; k < 2; ++k) dst[m][k] = *(const LAS bf16x8*)(lds + PG8_SA(b, h) + aoff + m * 2048 + k * 1024); } while (0)
#define PG8_LDB(dst, b, h) do { _Pragma("unroll") for (int n = 0; n < 2; ++n) _Pragma("unroll") for (int k = 0; k < 2; ++k) dst[n][k] = *(const LAS bf16x8*)(lds + PG8_SB(b, h) + boff + n * 2048 + k * 1024); } while (0)
#define PG8_MMA(ai, bj, At, Bt) do { __builtin_amdgcn_s_setprio(1); _Pragma("unroll") for (int m = 0; m < 4; ++m) _Pragma("unroll") for (int n = 0; n < 2; ++n) _Pragma("unroll") for (int k = 0; k < 2; ++k) \
        acc[ai][bj][m][n] = __builtin_amdgcn_mfma_f32_16x16x32_bf16(Bt[n][k], At[m][k], acc[ai][bj][m][n], 0, 0, 0); __builtin_amdgcn_s_setprio(0); } while (0)
#define PG8_WAIT_V(n) asm volatile("s_waitcnt vmcnt(" #n ")" ::: "memory")
#define PG8_WAIT_L(n) asm volatile("s_waitcnt lgkmcnt(" #n ")" ::: "memory")
#define PG8_BAR __builtin_amdgcn_s_barrier()
#define PG8_SCHED __builtin_amdgcn_sched_barrier(0)
    GUnit cur, nxt; int ui = 0;
    if (!S.next(0, cur)) return;
    f32x4 acc[2][2][4][2];
#pragma unroll
    for (int a = 0; a < 2; ++a)
#pragma unroll
        for (int b = 0; b < 2; ++b)
#pragma unroll
            for (int m = 0; m < 4; ++m)
#pragma unroll
                for (int n = 0; n < 2; ++n) acc[a][b][m][n] = (f32x4){0.f, 0.f, 0.f, 0.f};
    bf16x8 At[4][2], B0[2][2], B1[2][2];
    unsigned vg0[2], vg1[2];
    auto load_gather = [&](const GUnit& u, unsigned (&o0)[2], unsigned (&o1)[2]) {
#pragma unroll
        for (int i = 0; i < 2; ++i) {
            const int r0 = RA[i], r1 = 128 + RA[i];
            const int t0 = g.glist[u.pm + (r0 < u.e1 ? u.e0 + r0 : 0)], t1 = g.glist[u.pm + (r1 < u.e1 ? u.e0 + r1 : 0)];
            o0[i] = (unsigned)t0 * g.lda + voffA[i]; o1[i] = (unsigned)t1 * g.lda + voffA[i];
        }
    };
    const char* cA = cur.A; const char* cB = cur.B; const char* cB2 = cur.B2;
    if constexpr (GATHER) load_gather(cur, vg0, vg1);
#define PG8_A0(base, kt) (GATHER ? (base) + (size_t)(kt) * kstep : (base) + (size_t)(kt) * kstep)
#define PG8_STAGE_A0(bufoff, base, kt) do { if constexpr (GATHER) PG8_STAGE(bufoff, (base) + (size_t)(kt) * kstep, vg0); else PG8_STAGE(bufoff, (base) + (size_t)(kt) * kstep, voffA); } while (0)
#define PG8_STAGE_A1(bufoff, base, kt) do { if constexpr (GATHER) PG8_STAGE(bufoff, (base) + (size_t)(kt) * kstep, vg1); else PG8_STAGE(bufoff, (base) + hstepA + (size_t)(kt) * kstep, voffA); } while (0)
#define PG8_BP(B_, B2_, kt) ((SEGB && (kt) >= g.kseg) ? (B2_) + (size_t)((kt) - g.kseg) * kstep : (B_) + (size_t)(kt) * kstep)
    PG8_STAGE(PG8_SB(0, 0), cB, voffB); PG8_STAGE(PG8_SB(0, 1), cB + hstepB, voffB); PG8_STAGE_A0(PG8_SA(0, 0), cA, 0); PG8_STAGE_A1(PG8_SA(0, 1), cA, 0);
    if (wr == 1) PG8_BAR;
    PG8_WAIT_V(2); PG8_BAR;
    PG8_STAGE(PG8_SB(1, 0), cB + kstep, voffB); PG8_STAGE_A0(PG8_SA(1, 0), cA, 1); PG8_STAGE(PG8_SB(1, 1), cB + hstepB + kstep, voffB);
    PG8_WAIT_V(6); PG8_BAR;
    for (;;) {
        const bool has_next = S.next(ui + 1, nxt);
        const char* nA = has_next ? nxt.A : cA; const char* nB = has_next ? nxt.B : cB; const char* nB2 = has_next ? nxt.B2 : cB2;
        for (int t = 0; t < nt; t += 2) {
            const bool last = (t == nt - 2);
            unsigned ng0[2], ng1[2];
            if constexpr (GATHER) { if (last) { if (has_next) load_gather(nxt, ng0, ng1); else { ng0[0] = vg0[0]; ng0[1] = vg0[1]; ng1[0] = vg1[0]; ng1[1] = vg1[1]; } } }
            const char* b2 = last ? PG8_BP(nB, nB2, 0) : PG8_BP(cB, cB2, t + 2);
            const char* b3 = last ? PG8_BP(nB, nB2, 1) : PG8_BP(cB, cB2, t + 3);
            const char* a23 = last ? nA : cA; const int k2 = last ? 0 : t + 2, k3 = last ? 1 : t + 3;
            PG8_LDB(B0, 0, 0); PG8_LDB(B1, 0, 1); PG8_SCHED; PG8_LDA(At, 0, 0); PG8_STAGE_A1(PG8_SA(1, 1), cA, t + 1);
            PG8_WAIT_V(8); PG8_WAIT_L(0); PG8_BAR; PG8_MMA(0, 0, At, B0); PG8_MMA(0, 1, At, B1); PG8_BAR; PG8_SCHED;
            if constexpr (GATHER) { if (last) { vg0[0] = ng0[0]; vg0[1] = ng0[1]; vg1[0] = ng1[0]; vg1[1] = ng1[1]; } }
            PG8_LDA(At, 0, 1); PG8_STAGE(PG8_SB(0, 0), b2, voffB); PG8_STAGE(PG8_SB(0, 1), b2 + hstepB, voffB); PG8_STAGE_A0(PG8_SA(0, 0), a23, k2);
            PG8_WAIT_V(8); PG8_WAIT_L(0); PG8_BAR; PG8_MMA(1, 0, At, B0); PG8_MMA(1, 1, At, B1); PG8_BAR; PG8_SCHED;
            PG8_LDB(B0, 1, 0); PG8_LDB(B1, 1, 1); PG8_SCHED; PG8_LDA(At, 1, 0); PG8_STAGE_A1(PG8_SA(0, 1), a23, k2);
            PG8_WAIT_V(8); PG8_WAIT_L(0); PG8_BAR; PG8_MMA(0, 0, At, B0); PG8_MMA(0, 1, At, B1); PG8_BAR; PG8_SCHED;
            PG8_LDA(At, 1, 1); PG8_STAGE(PG8_SB(1, 0), b3, voffB); PG8_STAGE(PG8_SB(1, 1), b3 + hstepB, voffB); PG8_STAGE_A0(PG8_SA(1, 0), a23, k3);
            PG8_WAIT_V(8); PG8_WAIT_L(0); PG8_BAR; PG8_MMA(1, 0, At, B0); PG8_MMA(1, 1, At, B1); PG8_BAR; PG8_SCHED;
        }
        if (wr == 0) PG8_BAR;
        E(acc, cur, wr, wc, fr, fq);
        if (!has_next) break;
#pragma unroll
        for (int a = 0; a < 2; ++a)
#pragma unroll
            for (int b = 0; b < 2; ++b)
#pragma unroll
                for (int m = 0; m < 4; ++m)
#pragma unroll
                    for (int n = 0; n < 2; ++n) acc[a][b][m][n] = (f32x4){0.f, 0.f, 0.f, 0.f};
        cur = nxt; cA = nA; cB = nB; cB2 = nB2; ++ui;
        if (wr == 1) PG8_BAR;
    }
    PG8_WAIT_V(0);
    PG8_BAR;
#undef PG8_SA
#undef PG8_SB
#undef PG8_STAGE
#undef PG8_LDA
#undef PG8_LDB
#undef PG8_MMA
#undef PG8_WAIT_V
#undef PG8_WAIT_L
#undef PG8_BAR
#undef PG8_SCHED
#undef PG8_A0
#undef PG8_STAGE_A0
#undef PG8_STAGE_A1
#undef PG8_BP
}
struct TileOrder {
    int nM, nN, G, c; const char* A; const char* B; size_t tstepA, tstepB;
    __device__ __forceinline__ bool next(int i, GUnit& u) const {
        const int L = i * G + c; if (L >= nM * nN) return false;
        const int nig = 8 * nN, gid = L / nig, fm = gid * 8, gsz = (nM - fm) < 8 ? (nM - fm) : 8;
        u.pm = fm + ((L % nig) % gsz); u.pn = (L % nig) / gsz; u.A = A + (size_t)u.pm * tstepA; u.B = B + (size_t)u.pn * tstepB; u.B2 = nullptr; u.e0 = 0; u.e1 = 0; return true;
    }
};
__device__ __forceinline__ unsigned cvt_pk_bf16(float lo, float hi) { unsigned r; asm volatile("v_cvt_pk_bf16_f32 %0, %1, %2" : "=v"(r) : "v"(lo), "v"(hi)); return r; }
}

struct EpiProj {
    unsigned char* ws; const float* qg; const float* kg;
    __device__ __forceinline__ void operator()(const f32x4 (&acc)[2][2][4][2], const pg8::GUnit& u, int wr, int wc, int fr, int fq) const {
        const int region = u.pn >> 1, lc0 = (u.pn & 1) * 256 + 64 * wc + 8 * fq;
        bf16* base = (bf16*)(ws + WS_XL + (size_t)region * 32 * MiB);
        f32x4 gv[2][2];
        if (region == 2 || region == 3) {
            const float* g = (region == 2 ? qg : kg) + 8 * fq;
#pragma unroll
            for (int bj = 0; bj < 2; ++bj)
#pragma unroll
                for (int n = 0; n < 2; ++n) gv[bj][n] = *(const GAS f32x4*)(g + 32 * bj + 4 * n);
        }
#pragma unroll
        for (int ai = 0; ai < 2; ++ai)
#pragma unroll
            for (int m = 0; m < 4; ++m) {
                const size_t row = (size_t)u.pm * 256 + ai * 128 + wr * 64 + m * 16 + fr;
                f32x4 v[2][2];
#pragma unroll
                for (int bj = 0; bj < 2; ++bj)
#pragma unroll
                    for (int n = 0; n < 2; ++n) v[bj][n] = acc[ai][bj][m][n];
                if (region == 1) {
#pragma unroll
                    for (int bj = 0; bj < 2; ++bj)
#pragma unroll
                        for (int n = 0; n < 2; ++n) { v[bj][n].x = gelu_tanh(v[bj][n].x); v[bj][n].y = gelu_tanh(v[bj][n].y); v[bj][n].z = gelu_tanh(v[bj][n].z); v[bj][n].w = gelu_tanh(v[bj][n].w); }
                } else if (region == 2 || region == 3) {
                    float ss = 0.f;
#pragma unroll
                    for (int bj = 0; bj < 2; ++bj)
#pragma unroll
                        for (int n = 0; n < 2; ++n) ss += (v[bj][n].x * v[bj][n].x + v[bj][n].y * v[bj][n].y) + (v[bj][n].z * v[bj][n].z + v[bj][n].w * v[bj][n].w);
                    ss += __shfl_xor(ss, 16); ss += __shfl_xor(ss, 32);
                    const float rr = (1.0f / sqrtf(ss * (1.0f / HD) + EPS)) * (region == 2 ? C2 : 1.0f);
#pragma unroll
                    for (int bj = 0; bj < 2; ++bj)
#pragma unroll
                        for (int n = 0; n < 2; ++n) v[bj][n] = v[bj][n] * rr * gv[bj][n];
                }
                bf16* rowp = base + row * 512 + lc0;
#pragma unroll
                for (int bj = 0; bj < 2; ++bj) { v4u w; w.x = pg8::cvt_pk_bf16(v[bj][0].x, v[bj][0].y); w.y = pg8::cvt_pk_bf16(v[bj][0].z, v[bj][0].w); w.z = pg8::cvt_pk_bf16(v[bj][1].x, v[bj][1].y); w.w = pg8::cvt_pk_bf16(v[bj][1].z, v[bj][1].w);
                    *(GAS v4u*)(rowp + 32 * bj) = w; }
            }
    }
};
__device__ __forceinline__ void p1_fast(Frame& F, const Args& a) {
    pg8::GemmCfg g; g.nt = DM / 64; g.kseg = g.nt; g.lda = DM * 2; g.ldb = DM * 2; g.hstepA = (size_t)128 * DM * 2; g.hstepB = (size_t)32 * DM * 2; g.bmap = pg8::MAP_G64; g.glist = nullptr;
    pg8::TileOrder S; S.nM = T / 256; S.nN = INC / 256; S.G = F.G; S.c = F.vcu; S.A = (const char*)(F.ws + WS_XN); S.B = (const char*)(F.ws + WS_WIN); S.tstepA = (size_t)256 * DM * 2; S.tstepB = (size_t)256 * DM * 2;
    EpiProj E; E.ws = F.ws; E.qg = a.in[11]; E.kg = a.in[12];
    pg8::gemm_phase<EpiProj, pg8::TileOrder, false, false>(F.lds, g, S, E);
}

template <bool APPLY>
__device__ __forceinline__ void lru_chunk(Frame& F, const Args& a, int b, int j) {
    LAS float* XC = (LAS float*)F.lds;
    const int ch = F.tid; const size_t row0 = (size_t)b * SEQ + (size_t)j * 64;
    const bf16* XL = (const bf16*)(F.ws + WS_XL); const bf16* GL = (const bf16*)(F.ws + WS_GL);
    float* AGG = (float*)(F.ws + WS_AGG);
    __syncthreads();
    {
        const float cw0 = a.in[3][ch], cw1 = a.in[3][512 + ch], cw2 = a.in[3][1024 + ch], cw3 = a.in[3][1536 + ch], cb = a.in[4][ch];
        float x0 = 0.f, x1 = 0.f, x2 = 0.f;
        if (j > 0) { x0 = bf2f(XL[(row0 - 3) * 512 + ch]); x1 = bf2f(XL[(row0 - 2) * 512 + ch]); x2 = bf2f(XL[(row0 - 1) * 512 + ch]); }
#pragma unroll 8
        for (int t = 0; t < 64; ++t) {
            const float x3 = bf2f(XL[(row0 + t) * 512 + ch]);
            XC[t * 512 + ch] = cb + cw0 * x0 + cw1 * x1 + cw2 * x2 + cw3 * x3;
            x0 = x1; x1 = x2; x2 = x3;
        }
    }
    __syncthreads();
    float ra[64], ri[64];
#pragma unroll
    for (int t = 0; t < 64; ++t) { ra[t] = 0.f; ri[t] = 0.f; }
    {
        const int blk = ch >> 6, d = ch & 63;
        const float* Wa = a.in[5] + blk * 4096 + d; const float* Wx = a.in[7] + blk * 4096 + d;
        const LAS float* xb = XC + blk * 64;
#pragma unroll 1
        for (int c = 0; c < 64; c += 4) {
            const float wa0 = Wa[(c + 0) * 64], wa1 = Wa[(c + 1) * 64], wa2 = Wa[(c + 2) * 64], wa3 = Wa[(c + 3) * 64];
            const float wx0 = Wx[(c + 0) * 64], wx1 = Wx[(c + 1) * 64], wx2 = Wx[(c + 2) * 64], wx3 = Wx[(c + 3) * 64];
#pragma unroll
            for (int t = 0; t < 64; ++t) {
                const f32x4 xv = *(const LAS f32x4*)&xb[t * 512 + c];
                ra[t] += xv.x * wa0 + xv.y * wa1 + xv.z * wa2 + xv.w * wa3;
                ri[t] += xv.x * wx0 + xv.y * wx1 + xv.z * wx2 + xv.w * wx3;
            }
        }
    }
    __syncthreads();
    const float sp = log1pf(expf(-a.in[9][ch]));
    const float ba = a.in[6][ch], bx = a.in[8][ch];
    float h = 0.f, lasum = 0.f;
    if (APPLY) {
        for (int i = 0; i < j; ++i) { const float A = AGG[((size_t)(b * 32 + i) * 2 + 0) * 512 + ch], H = AGG[((size_t)(b * 32 + i) * 2 + 1) * 512 + ch]; h = A * h + H; }
    }
#pragma unroll
    for (int t = 0; t < 64; ++t) {
        const float xc = XC[t * 512 + ch];
        const float rg = sigmoidf_(ra[t] + ba), ig = sigmoidf_(ri[t] + bx);
        const float la = -8.0f * rg * sp;
        const float av = expf(la);
        const float u = sqrtf(-expm1f(2.0f * la)) * (ig * xc);
        h = av * h + u;
        if (APPLY) XC[t * 512 + ch] = h * bf2f(GL[(row0 + t) * 512 + ch]);
        else lasum += la;
    }
    if (!APPLY) {
        AGG[((size_t)(b * 32 + j) * 2 + 0) * 512 + ch] = expf(lasum);
        AGG[((size_t)(b * 32 + j) * 2 + 1) * 512 + ch] = h;
        return;
    }
    __syncthreads();
    bf16* Y = (bf16*)(F.ws + WS_Y);
    const f32x4 g0 = *(const GAS f32x4*)(a.in[10] + F.lane * 8), g1 = *(const GAS f32x4*)(a.in[10] + F.lane * 8 + 4);
#pragma unroll
    for (int i = 0; i < 8; ++i) {
        const int t = F.wave + 8 * i;
        const f32x4 y0 = *(const LAS f32x4*)&XC[t * 512 + F.lane * 8], y1 = *(const LAS f32x4*)&XC[t * 512 + F.lane * 8 + 4];
        float ss = (y0.x * y0.x + y0.y * y0.y) + (y0.z * y0.z + y0.w * y0.w) + (y1.x * y1.x + y1.y * y1.y) + (y1.z * y1.z + y1.w * y1.w);
        const float r = 1.0f / sqrtf(wave_sum(ss) * (1.0f / LW) + EPS);
        v4u o; o.x = pk2(y0.x * r * g0.x, y0.y * r * g0.y); o.y = pk2(y0.z * r * g0.z, y0.w * r * g0.w); o.z = pk2(y1.x * r * g1.x, y1.y * r * g1.y); o.w = pk2(y1.z * r * g1.z, y1.w * r * g1.w);
        *(GAS v4u*)(Y + (row0 + t) * DM + F.lane * 8) = o;
    }
}

__device__ __forceinline__ void nattn_unit(Frame& F, const Args& a, int b, int h, int c, float lam) {
    LAS float* Qs = (LAS float*)F.lds; LAS float* Ks = Qs + 64 * 132; LAS float* Vs = Ks + 64 * 132; LAS float* Ps = Vs + 64 * 132;
    const bf16* Qg = (const bf16*)(F.ws + WS_Q); const bf16* Kg = (const bf16*)(F.ws + WS_K); const bf16* Vg = (const bf16*)(F.ws + WS_V);
    const int tid = F.tid, qi = tid >> 3, sub = tid & 7;
    const float slope2 = exp2f(-2.0f * (float)(h + 1)) * LOG2E;
    __syncthreads();
    {
        const bf16* src = Qg + ((size_t)b * SEQ + 64 * c + qi) * 512 + h * 128 + sub * 16;
        const v4u v0 = *(const GAS v4u*)src, v1 = *(const GAS v4u*)(src + 8);
        LAS float* d = Qs + qi * 132 + sub * 16;
#pragma unroll
        for (int i = 0; i < 4; ++i) { d[2 * i] = bflo(v0[i]); d[2 * i + 1] = bfhi(v0[i]); d[8 + 2 * i] = bflo(v1[i]); d[8 + 2 * i + 1] = bfhi(v1[i]); }
    }
    float m0 = -1e30f, m1 = -1e30f, l0 = 0.f, l1 = 0.f, O0[16], O1[16];
#pragma unroll
    for (int i = 0; i < 16; ++i) { O0[i] = 0.f; O1[i] = 0.f; }
    for (int kt = 0; kt <= c; ++kt) {
        __syncthreads();
        {
            const size_t off = ((size_t)b * SEQ + 64 * kt + qi) * 512 + h * 128 + sub * 16;
            const v4u k0 = *(const GAS v4u*)(Kg + off), k1 = *(const GAS v4u*)(Kg + off + 8);
            const v4u v0 = *(const GAS v4u*)(Vg + off), v1 = *(const GAS v4u*)(Vg + off + 8);
            LAS float* dk = Ks + qi * 132 + sub * 16; LAS float* dv = Vs + qi * 132 + sub * 16;
#pragma unroll
            for (int i = 0; i < 4; ++i) {
                dk[2 * i] = bflo(k0[i]); dk[2 * i + 1] = bfhi(k0[i]); dk[8 + 2 * i] = bflo(k1[i]); dk[8 + 2 * i + 1] = bfhi(k1[i]);
                dv[2 * i] = bflo(v0[i]); dv[2 * i + 1] = bfhi(v0[i]); dv[8 + 2 * i] = bflo(v1[i]); dv[8 + 2 * i + 1] = bfhi(v1[i]);
            }
        }
        __syncthreads();
        float e0[8], e1[8];
#pragma unroll
        for (int j = 0; j < 8; ++j) {
            const int kk = sub + 8 * j;
            float s0 = 0.f, s1 = 0.f;
#pragma unroll
            for (int d = 0; d < 64; d += 4) {
                const f32x4 q0 = *(const LAS f32x4*)&Qs[qi * 132 + d], k0 = *(const LAS f32x4*)&Ks[kk * 132 + d];
                const f32x4 q1 = *(const LAS f32x4*)&Qs[qi * 132 + 64 + d], k1 = *(const LAS f32x4*)&Ks[kk * 132 + 64 + d];
                s0 += (q0.x * k0.x + q0.y * k0.y) + (q0.z * k0.z + q0.w * k0.w);
                s1 += (q1.x * k1.x + q1.y * k1.y) + (q1.z * k1.z + q1.w * k1.w);
            }
            const int dist = (64 * c + qi) - (64 * kt + kk);
            const float bias = -slope2 * (float)(dist < 0 ? -dist : dist);
            e0[j] = s0 + bias; e1[j] = s1 + bias;
        }
        {
            float tm = e0[0];
#pragma unroll
            for (int j = 1; j < 8; ++j) tm = fmaxf(tm, e0[j]);
            tm = max8lanes(tm);
            const float mn = fmaxf(m0, tm), al = exp2f(m0 - mn);
            float ps = 0.f;
#pragma unroll
            for (int j = 0; j < 8; ++j) { const float p = exp2f(e0[j] - mn); ps += p; Ps[qi * 65 + sub + 8 * j] = p; }
            ps = sum8lanes(ps);
            l0 = l0 * al + ps; m0 = mn;
#pragma unroll
            for (int i = 0; i < 16; ++i) O0[i] *= al;
        }
        {
            float tm = e1[0];
#pragma unroll
            for (int j = 1; j < 8; ++j) tm = fmaxf(tm, e1[j]);
            tm = max8lanes(tm);
            const float mn = fmaxf(m1, tm), al = exp2f(m1 - mn);
            float ps = 0.f;
#pragma unroll
            for (int j = 0; j < 8; ++j) { const float p = exp2f(e1[j] - mn); ps += p; Ps[(64 + qi) * 65 + sub + 8 * j] = p; }
            ps = sum8lanes(ps);
            l1 = l1 * al + ps; m1 = mn;
#pragma unroll
            for (int i = 0; i < 16; ++i) O1[i] *= al;
        }
        __syncthreads();
#pragma unroll 4
        for (int kk = 0; kk < 64; ++kk) {
            const float p0 = Ps[qi * 65 + kk], p1 = Ps[(64 + qi) * 65 + kk];
            const LAS f32x4* vp = (const LAS f32x4*)&Vs[kk * 132 + sub * 16];
#pragma unroll
            for (int q = 0; q < 4; ++q) { const f32x4 v = vp[q];
                O0[4 * q] += p0 * v.x; O0[4 * q + 1] += p0 * v.y; O0[4 * q + 2] += p0 * v.z; O0[4 * q + 3] += p0 * v.w;
                O1[4 * q] += p1 * v.x; O1[4 * q + 1] += p1 * v.y; O1[4 * q + 2] += p1 * v.z; O1[4 * q + 3] += p1 * v.w; }
        }
    }
    const float il0 = 1.0f / l0, il1 = lam / l1;
    float o[16], ss = 0.f;
#pragma unroll
    for (int i = 0; i < 16; ++i) { o[i] = O0[i] * il0 - O1[i] * il1; ss += o[i] * o[i]; }
    ss = sum8lanes(ss);
    const float r = (1.0f / sqrtf(ss * (1.0f / VD) + EPS)) * 0.8f;
    const float* sg = a.in[17] + sub * 16;
    float o8a[8], o8b[8];
#pragma unroll
    for (int i = 0; i < 8; ++i) { o8a[i] = o[i] * r * sg[i]; o8b[i] = o[8 + i] * r * sg[8 + i]; }
    bf16* dst = (bf16*)(F.ws + WS_Y) + ((size_t)b * SEQ + 64 * c + qi) * DM + 512 + h * 128 + sub * 16;
    *(GAS v4u*)dst = pack8(o8a); *(GAS v4u*)(dst + 8) = pack8(o8b);
}
__device__ __forceinline__ float diff_lambda(const Args& a) {
    float s1 = 0.f, s2 = 0.f;
    for (int i = 0; i < HD; ++i) { s1 += a.in[13][i] * a.in[14][i]; s2 += a.in[15][i] * a.in[16][i]; }
    return expf(s1) - expf(s2) + 0.2f;
}
__device__ __forceinline__ void p3_simple(Frame& F, const Args& a) {
    const float lam = diff_lambda(a);
    for (int i = F.vcu; i < BATCH * NH * 32; i += F.G) { const int c = 31 - (i >> 6), bh = i & 63; nattn_unit(F, a, bh >> 2, bh & 3, c, lam); }
    for (int i = F.vcu; i < BATCH * 32; i += F.G) lru_chunk<true>(F, a, i >> 5, i & 31);
}


namespace da {
typedef float f32x16 __attribute__((ext_vector_type(16)));
typedef short bf16x8 __attribute__((ext_vector_type(8)));
typedef short s16x4 __attribute__((ext_vector_type(4)));
typedef __attribute__((address_space(3))) const char* lds_cptr;
constexpr int L_K = 0, L_V = 32768, L_WS = 65536, L_STG = 65536 + 2048, L_END = L_STG + 4 * 8192;
__device__ __forceinline__ int crow(int r, int hi) { return (r & 3) + 8 * (r >> 2) + 4 * hi; }
typedef float f32x2_t __attribute__((ext_vector_type(2))); typedef __bf16 bf16x2_t __attribute__((ext_vector_type(2)));
__device__ __forceinline__ unsigned cvtpk(float lo, float hi) { f32x2_t v = {lo, hi}; bf16x2_t b = __builtin_convertvector(v, bf16x2_t); return __builtin_bit_cast(unsigned, b); }
__device__ __forceinline__ s16x4 vtr(lds_cptr p) { return __builtin_bit_cast(s16x4, __builtin_amdgcn_ds_read_tr16_b64_v4i16((__attribute__((address_space(3))) s16x4*)p)); }

__device__ __forceinline__ void unit(LAS unsigned char* lds, const bf16* Qg, const bf16* Kg, const bf16* Vg, bf16* Yg, const float* subg, int b, int h, int qb, float lam) {
    const int tid = opaque_tid(), lane = tid & 63, r32 = lane & 31, hi = lane >> 5; const int wid = __builtin_amdgcn_readfirstlane(tid >> 6);
    const int comp = wid >> 2, rb = wid & 3, co = rb >> 1;
    const int cq = 2 * qb + co, NT = 2 * qb + 2;
    const size_t rowbase = (size_t)b * SEQ; const int qrow0 = 128 * qb + 32 * rb;
    const float sl2 = exp2f(-2.0f * (float)(h + 1)) * LOG2E;
    bf16x8 qr[4];
    { const bf16* Qw = Qg + (rowbase + qrow0 + r32) * 512 + h * 128 + comp * 64 + hi * 8;
#pragma unroll
      for (int d0 = 0; d0 < 4; ++d0) qr[d0] = *(const GAS bf16x8*)(Qw + d0 * 16); }
    const bf16* ksrc = Kg + (rowbase + lane) * 512 + h * 128 + wid * 8;
    const bf16* vsrc = Vg + (rowbase + 16 * (wid & 3) + (lane >> 2)) * 512 + h * 128 + (wid >> 2) * 32 + (lane & 3) * 8;
#define DA_DMA(t, slot) do { const size_t _o = (size_t)(t) * 64 * 512; \
        __builtin_amdgcn_global_load_lds((const unsigned*)(ksrc + _o), (LAS unsigned*)(lds + L_K + (slot) * 16384 + wid * 1024), 16, 0, 0); \
        __builtin_amdgcn_global_load_lds((const unsigned*)(ksrc + _o + 64), (LAS unsigned*)(lds + L_K + (slot) * 16384 + 8192 + wid * 1024), 16, 0, 0); \
        __builtin_amdgcn_global_load_lds((const unsigned*)(vsrc + _o), (LAS unsigned*)(lds + L_V + (slot) * 16384 + wid * 1024), 16, 0, 0); \
        __builtin_amdgcn_global_load_lds((const unsigned*)(vsrc + _o + 64), (LAS unsigned*)(lds + L_V + (slot) * 16384 + (wid + 8) * 1024), 16, 0, 0); } while (0)
    f32x16 o[4];
#pragma unroll
    for (int d0 = 0; d0 < 4; ++d0)
#pragma unroll
        for (int r = 0; r < 16; ++r) o[d0][r] = 0.f;
    float l = 0.f;
    const float qrel = (float)(32 * (rb & 1) + r32);
    const lds_cptr kp0 = (lds_cptr)lds + L_K + comp * 8192 + hi * 1024 + r32 * 16;
    const lds_cptr vp0 = (lds_cptr)lds + L_V + ((lane >> 4) & 1) * 32 + (lane & 3) * 8 + (4 * hi + ((lane & 15) >> 2)) * 64;
    DA_DMA(0, 0);
    for (int t = 0; t < NT; ++t) {
        __syncthreads();
        if (t + 1 < NT) DA_DMA(t + 1, (t + 1) & 1);
        if (t <= cq) {
            const int slot = t & 1;
            f32x16 p0, p1;
            if (t < cq) {
                const float base = -sl2 * ((float)(64 * (cq - t)) + qrel - (float)(4 * hi));
#pragma unroll
                for (int r = 0; r < 16; ++r) { p0[r] = base + sl2 * (float)((r & 3) + 8 * (r >> 2)); p1[r] = p0[r] + 32.0f * sl2; }
            } else {
#pragma unroll
                for (int r = 0; r < 16; ++r) { const float d = qrel - (float)(4 * hi) - (float)((r & 3) + 8 * (r >> 2)); p0[r] = -sl2 * fabsf(d); p1[r] = -sl2 * fabsf(d - 32.0f); }
            }
            const lds_cptr kp = kp0 + slot * 16384;
#pragma unroll
            for (int d0 = 0; d0 < 4; ++d0) {
                const bf16x8 k0 = *(const LAS bf16x8*)(kp + d0 * 2048), k1 = *(const LAS bf16x8*)(kp + d0 * 2048 + 512);
                p0 = __builtin_amdgcn_mfma_f32_32x32x16_bf16(k0, qr[d0], p0, 0, 0, 0);
                p1 = __builtin_amdgcn_mfma_f32_32x32x16_bf16(k1, qr[d0], p1, 0, 0, 0);
            }
            float sacc = 0.f;
#pragma unroll
            for (int r = 0; r < 16; ++r) { p0[r] = __builtin_amdgcn_exp2f(p0[r]); p1[r] = __builtin_amdgcn_exp2f(p1[r]); sacc += p0[r] + p1[r]; }
            l += sacc;
            bf16x8 pa[4];
            { unsigned w[16];
#pragma unroll
              for (int i = 0; i < 8; ++i) { w[i] = cvtpk(p0[2 * i], p0[2 * i + 1]); w[8 + i] = cvtpk(p1[2 * i], p1[2 * i + 1]); }
#pragma unroll
              for (int k = 0; k < 4; ++k) { v4u x = {w[4 * k], w[4 * k + 1], w[4 * k + 2], w[4 * k + 3]}; pa[k] = __builtin_bit_cast(bf16x8, x); } }
            const lds_cptr vp = vp0 + slot * 16384;
#pragma unroll
            for (int d0 = 0; d0 < 4; ++d0) {
#pragma unroll
                for (int ks = 0; ks < 4; ++ks) {
                    const s16x4 lo = vtr(vp + d0 * 4096 + ks * 1024), hh = vtr(vp + d0 * 4096 + ks * 1024 + 512);
                    const bf16x8 vf = {lo[0], lo[1], lo[2], lo[3], hh[0], hh[1], hh[2], hh[3]};
                    o[d0] = __builtin_amdgcn_mfma_f32_32x32x16_bf16(pa[ks], vf, o[d0], 0, 0, 0);
                }
            }
        }
    }
#undef DA_DMA
    { auto rr = __builtin_amdgcn_permlane32_swap(__float_as_uint(l), __float_as_uint(l), false, false); l = __uint_as_float(rr[0]) + __uint_as_float(rr[1]); }
    __syncthreads();
    LAS float* wsf = (LAS float*)(lds + L_WS) + wid * 64;
    if (hi == 0) wsf[r32] = l;
    asm volatile("s_waitcnt lgkmcnt(0)" ::: "memory");
    float rl[16];
#pragma unroll
    for (int r = 0; r < 16; ++r) rl[r] = (comp ? lam : 1.0f) / wsf[crow(r, hi)];
    LAS float* X = (LAS float*)lds + rb * 4096 + lane;
    if (comp == 1) {
#pragma unroll
        for (int d0 = 0; d0 < 4; ++d0)
#pragma unroll
            for (int r = 0; r < 16; ++r) X[(d0 * 16 + r) * 64] = o[d0][r] * rl[r];
    }
    __syncthreads();
    if (comp == 0) {
        float rn[16];
#pragma unroll
        for (int r = 0; r < 16; ++r) {
            float ss = 0.f;
#pragma unroll
            for (int d0 = 0; d0 < 4; ++d0) { o[d0][r] = o[d0][r] * rl[r] - X[(d0 * 16 + r) * 64]; ss += o[d0][r] * o[d0][r]; }
            ss += __shfl_xor(ss, 1); ss += __shfl_xor(ss, 2); ss += __shfl_xor(ss, 4); ss += __shfl_xor(ss, 8); ss += __shfl_xor(ss, 16);
            rn[r] = (1.0f / sqrtf(ss * (1.0f / VD) + EPS)) * 0.8f;
        }
        LAS bf16* stg = (LAS bf16*)(lds + L_STG) + wid * 4096;
#pragma unroll
        for (int d0 = 0; d0 < 4; ++d0) { const float gg = subg[32 * d0 + r32];
#pragma unroll
            for (int r = 0; r < 16; ++r) stg[crow(r, hi) * 128 + 32 * d0 + r32] = (bf16)f2bf(o[d0][r] * rn[r] * gg); }
        asm volatile("s_waitcnt lgkmcnt(0)" ::: "memory");
        bf16* Yw = Yg + (rowbase + qrow0) * DM + 512 + h * 128;
#pragma unroll
        for (int i = 0; i < 8; ++i) { const int row = i * 4 + (lane >> 4), ch = lane & 15; const v4u v = *(const LAS v4u*)(stg + row * 128 + ch * 8); *(GAS v4u*)(Yw + (size_t)row * DM + ch * 8) = v; }
    }
    __syncthreads();
}
}
__device__ __forceinline__ void p3_fast(Frame& F, const Args& a) {
    const float lam = diff_lambda(a);
    const bf16* Qg = (const bf16*)(F.ws + WS_Q); const bf16* Kg = (const bf16*)(F.ws + WS_K); const bf16* Vg = (const bf16*)(F.ws + WS_V); bf16* Yg = (bf16*)(F.ws + WS_Y);
    for (int P = F.vcu; P < BATCH * NH * 8; P += F.G) {
        const int bh = P >> 3, s = P & 7;
        da::unit(F.lds, Qg, Kg, Vg, Yg, a.in[17], bh >> 2, bh & 3, 15 - s, lam);
        da::unit(F.lds, Qg, Kg, Vg, Yg, a.in[17], bh >> 2, bh & 3, s, lam);
    }
    for (int i = F.vcu; i < BATCH * 32; i += F.G) lru_chunk<true>(F, a, i >> 5, i & 31);
}

__device__ __forceinline__ void p4_simple(Frame& F, const Args& a) {
    LAS float* As = (LAS float*)F.lds; LAS float* Bs = As + 64 * 65;
    const bf16* Y = (const bf16*)(F.ws + WS_Y); const bf16* Wout_t = (const bf16*)(F.ws + WS_WOUT);
    const int tid = F.tid, r = tid >> 3, cg = tid & 7;
    for (int tt = F.vcu; tt < (T / 64) * 16; tt += F.G) {
        const int rt = tt >> 4, ct = tt & 15;
        float acc[8] = {0.f, 0.f, 0.f, 0.f, 0.f, 0.f, 0.f, 0.f};
        ngemm_acc(As, Bs, DM, [&](int rr) { return Y + (size_t)(rt * 64 + rr) * DM; }, [&](int cc) { return Wout_t + (size_t)(ct * 64 + cc) * DM; }, acc);
        const size_t off = ((size_t)rt * 64 + r) * DM + ct * 64 + cg * 8;
        const f32x4 x0 = *(const GAS f32x4*)(a.in[0] + off), x1 = *(const GAS f32x4*)(a.in[0] + off + 4);
        *(GAS f32x4*)(F.out + off) = (f32x4){x0.x + acc[0], x0.y + acc[1], x0.z + acc[2], x0.w + acc[3]};
        *(GAS f32x4*)(F.out + off + 4) = (f32x4){x1.x + acc[4], x1.y + acc[5], x1.z + acc[6], x1.w + acc[7]};
    }
}

__device__ __forceinline__ void p5_route(Frame& F, const Args& a) {
    LAS float* Wr = (LAS float*)F.lds;
    __syncthreads();
    for (int i = F.tid; i < 20 * 1024; i += NTHR) {
        const int c = i >> 10, k = i & 1023;
        Wr[i] = (c < 4) ? a.in[20][k * 4 + c] : a.in[22][((size_t)((c - 4) >> 2) * 1024 + k) * 4 + ((c - 4) & 3)];
    }
    __syncthreads();
    const int gw = F.vcu * NWAVES + F.wave, NGW = F.G * NWAVES, lane = F.lane;
    bf16* HN2 = (bf16*)(F.ws + WS_XN); float* gates = (float*)(F.ws + WS_GATES); int* list = (int*)(F.ws + WS_LIST);
    const GAS f32x4* gr = (const GAS f32x4*)a.in[19] + lane;
    for (int m = gw; m < T; m += NGW) {
        const GAS f32x4* xr = (const GAS f32x4*)(F.out + (size_t)m * DM) + lane;
        f32x4 v[4]; float s = 0.f;
#pragma unroll
        for (int j = 0; j < 4; ++j) { v[j] = xr[64 * j]; s += (v[j].x * v[j].x + v[j].y * v[j].y) + (v[j].z * v[j].z + v[j].w * v[j].w); }
        const float r = 1.0f / sqrtf(wave_sum(s) * (1.0f / DM) + EPS);
        GAS v2u* o8 = (GAS v2u*)(HN2 + (size_t)m * DM) + lane;
#pragma unroll
        for (int j = 0; j < 4; ++j) { const f32x4 gg = gr[64 * j]; v[j].x *= r * gg.x; v[j].y *= r * gg.y; v[j].z *= r * gg.z; v[j].w *= r * gg.w;
            v2u w; w.x = pk2(v[j].x, v[j].y); w.y = pk2(v[j].z, v[j].w); o8[64 * j] = w; }
        float lg[20];
#pragma unroll
        for (int c = 0; c < 20; ++c) {
            float acc = 0.f;
#pragma unroll
            for (int j = 0; j < 4; ++j) { const f32x4 w = *(const LAS f32x4*)&Wr[c * 1024 + 256 * j + 4 * lane]; acc += (v[j].x * w.x + v[j].y * w.y) + (v[j].z * w.z + v[j].w * w.w); }
            lg[c] = wave_sum(acc);
            asm volatile("" ::: "memory");
        }
        float gl0 = lg[0] + a.in[21][0], gl1 = lg[1] + a.in[21][1], gl2 = lg[2] + a.in[21][2], gl3 = lg[3] + a.in[21][3];
        int gi = 0; float gm = gl0;
        if (gl1 > gm) { gm = gl1; gi = 1; } if (gl2 > gm) { gm = gl2; gi = 2; } if (gl3 > gm) { gm = gl3; gi = 3; }
        const float pg = 1.0f / (expf(gl0 - gm) + expf(gl1 - gm) + expf(gl2 - gm) + expf(gl3 - gm));
        float el[4];
#pragma unroll
        for (int e = 0; e < 4; ++e) { const float sel = gi == 0 ? lg[4 + e] : gi == 1 ? lg[8 + e] : gi == 2 ? lg[12 + e] : lg[16 + e]; el[e] = sel + a.in[23][gi * 4 + e]; }
        int e1 = 0; float v1 = el[0];
#pragma unroll
        for (int e = 1; e < 4; ++e) if (el[e] > v1) { v1 = el[e]; e1 = e; }
        int e2 = -1; float v2 = -3.0e38f;
#pragma unroll
        for (int e = 0; e < 4; ++e) if (e != e1 && el[e] > v2) { v2 = el[e]; e2 = e; }
        const float w1 = 1.0f / (1.0f + expf(v2 - v1)), w2 = 1.0f - w1;
        const int lo = e1 < e2 ? e1 : e2, hi = e1 < e2 ? e2 : e1;
        const float glo = pg * (e1 < e2 ? w1 : w2), ghi = pg * (e1 < e2 ? w2 : w1);
        const int pi = lo == 0 ? hi - 1 : (lo == 1 ? hi + 1 : 5);
        const int bk = gi * 6 + pi;
        if (lane == 0) {
            const unsigned slot = __hip_atomic_fetch_add((unsigned*)(F.ctl + CW_CNT + bk), 1u, RLX_AGENT);
            list[(size_t)bk * T + slot] = m; gates[2 * (size_t)m] = glo; gates[2 * (size_t)m + 1] = ghi;
            float* gp = (float*)(F.ws + WS_GPOS) + ((size_t)bk * T + slot) * 2; gp[0] = glo; gp[1] = ghi;
        }
    }
}

__device__ __forceinline__ void bucket_tables(Frame& F, LAS int* tb) {
    __syncthreads();
    if (F.tid == 0) {
        int off = 0, pre = 0;
        for (int k = 0; k < NBK; ++k) {
            const int c = (int)__hip_atomic_load((unsigned*)(F.ctl + CW_CNT + k), RLX_AGENT);
            tb[k] = c; tb[24 + k] = off; tb[49 + k] = pre; off += (c + 255) & ~255; pre += (c + 63) >> 6;
        }
        tb[24 + 24] = off; tb[49 + 24] = pre;
    }
    __syncthreads();
}
__device__ __forceinline__ void bk_experts(int bk, int& elo, int& ehi) {
    const int g = bk / 6, pi = bk % 6;
    const int lo = pi < 3 ? 0 : (pi < 5 ? 1 : 2), hi = pi < 3 ? pi + 1 : (pi < 5 ? pi - 1 : 3);
    elo = g * 4 + lo; ehi = g * 4 + hi;
}

__device__ __forceinline__ void p6_simple(Frame& F, const Args& a) {
    LAS float* As = (LAS float*)F.lds; LAS float* Bs = As + 64 * 65; LAS int* tb = (LAS int*)(Bs + 64 * 72);
    bucket_tables(F, tb);
    const bf16* HN2 = (const bf16*)(F.ws + WS_XN); const bf16* Wg_t = (const bf16*)(F.ws + WS_WG); const bf16* Wu_t = (const bf16*)(F.ws + WS_WU);
    const float* gates = (const float*)(F.ws + WS_GATES); const int* list = (const int*)(F.ws + WS_LIST);
    bf16* HID = (bf16*)(F.ws + WS_HID);
    const int tid = F.tid, r = tid >> 3, cg = tid & 7;
    const int ntile = tb[49 + 24];
    for (int u = F.vcu; u < ntile * 16; u += F.G) {
        const int tile = u >> 4, x = (u >> 3) & 1, jt = u & 7;
        int bk = 0;
        for (int k = 1; k < NBK; ++k) if (tile >= tb[49 + k]) bk = k;
        const int rt = tile - tb[49 + bk], cnt = tb[bk], off = tb[24 + bk];
        int elo, ehi; bk_experts(bk, elo, ehi); const int e = x ? ehi : elo;
        const int idx = rt * 64 + r; const bool valid = idx < cnt;
        const int tok = list[(size_t)bk * T + (valid ? idx : 0)];
        const float gate = valid ? gates[2 * (size_t)tok + x] : 0.f;
        float ag[8] = {0.f, 0.f, 0.f, 0.f, 0.f, 0.f, 0.f, 0.f}, au[8] = {0.f, 0.f, 0.f, 0.f, 0.f, 0.f, 0.f, 0.f};
        ngemm_acc(As, Bs, DM, [&](int) { return HN2 + (size_t)tok * DM; }, [&](int cc) { return Wg_t + ((size_t)e * DE + jt * 64 + cc) * DM; }, ag);
        ngemm_acc(As, Bs, DM, [&](int) { return HN2 + (size_t)tok * DM; }, [&](int cc) { return Wu_t + ((size_t)e * DE + jt * 64 + cc) * DM; }, au);
        float hv[8];
#pragma unroll
        for (int j = 0; j < 8; ++j) hv[j] = ag[j] * sigmoidf_(ag[j]) * au[j] * gate;
        *(GAS v4u*)(HID + (size_t)(off + idx) * DM + x * 512 + jt * 64 + cg * 8) = pack8(hv);
    }
}
__device__ __forceinline__ void p7_simple(Frame& F, const Args& a) {
    LAS float* As = (LAS float*)F.lds; LAS float* Bs = As + 64 * 65; LAS int* tb = (LAS int*)(Bs + 64 * 72);
    bucket_tables(F, tb);
    const bf16* HID = (const bf16*)(F.ws + WS_HID); const bf16* Wd_t = (const bf16*)(F.ws + WS_WD);
    const int* list = (const int*)(F.ws + WS_LIST);
    const int tid = F.tid, r = tid >> 3, cg = tid & 7;
    const int ntile = tb[49 + 24];
    for (int u = F.vcu; u < ntile * 16; u += F.G) {
        const int tile = u >> 4, ct = u & 15;
        int bk = 0;
        for (int k = 1; k < NBK; ++k) if (tile >= tb[49 + k]) bk = k;
        const int rt = tile - tb[49 + bk], cnt = tb[bk], off = tb[24 + bk];
        int elo, ehi; bk_experts(bk, elo, ehi);
        const int idx = rt * 64 + r; const bool valid = idx < cnt;
        float acc[8] = {0.f, 0.f, 0.f, 0.f, 0.f, 0.f, 0.f, 0.f};
        ngemm_acc(As, Bs, DE, [&](int rr) { return HID + (size_t)(off + rt * 64 + rr) * DM; }, [&](int cc) { return Wd_t + ((size_t)elo * DM + ct * 64 + cc) * DE; }, acc);
        ngemm_acc(As, Bs, DE, [&](int rr) { return HID + (size_t)(off + rt * 64 + rr) * DM + 512; }, [&](int cc) { return Wd_t + ((size_t)ehi * DM + ct * 64 + cc) * DE; }, acc);
        if (valid) {
            const int tok = list[(size_t)bk * T + idx];
            const size_t o = (size_t)tok * DM + ct * 64 + cg * 8;
            const f32x4 h0 = *(const GAS f32x4*)(F.out + o), h1 = *(const GAS f32x4*)(F.out + o + 4);
            *(GAS f32x4*)(F.out + o) = (f32x4){h0.x + acc[0], h0.y + acc[1], h0.z + acc[2], h0.w + acc[3]};
            *(GAS f32x4*)(F.out + o + 4) = (f32x4){h1.x + acc[4], h1.y + acc[5], h1.z + acc[6], h1.w + acc[7]};
        }
    }
}


struct EpiOutRes {
    const float* x; float* out;
    __device__ __forceinline__ void operator()(const f32x4 (&acc)[2][2][4][2], const pg8::GUnit& u, int wr, int wc, int fr, int fq) const {
        const size_t row0 = (size_t)u.pm * 256 + wr * 64 + fr; const int col0 = u.pn * 256 + wc * 32 + 4 * fq;
#pragma unroll
        for (int ai = 0; ai < 2; ++ai)
#pragma unroll
            for (int m = 0; m < 4; ++m) { const size_t off = (row0 + ai * 128 + m * 16) * DM + col0;
#pragma unroll
                for (int bj = 0; bj < 2; ++bj)
#pragma unroll
                    for (int n = 0; n < 2; ++n) { const f32x4 xv = *(const GAS f32x4*)(x + off + bj * 128 + n * 16); *(GAS f32x4*)(out + off + bj * 128 + n * 16) = xv + acc[ai][bj][m][n]; }
                if (m & 1) asm volatile("" ::: "memory"); }
    }
};
__device__ __forceinline__ void p4_fast(Frame& F, const Args& a) {
    pg8::GemmCfg g; g.nt = DM / 64; g.kseg = g.nt; g.lda = DM * 2; g.ldb = DM * 2; g.hstepA = (size_t)128 * DM * 2; g.hstepB = (size_t)128 * DM * 2; g.bmap = pg8::MAP_NAT; g.glist = nullptr;
    pg8::TileOrder S; S.nM = T / 256; S.nN = DM / 256; S.G = F.G; S.c = F.vcu; S.A = (const char*)(F.ws + WS_Y); S.B = (const char*)(F.ws + WS_WOUT); S.tstepA = (size_t)256 * DM * 2; S.tstepB = (size_t)256 * DM * 2;
    EpiOutRes E; E.x = a.in[0]; E.out = F.out;
    pg8::gemm_phase<EpiOutRes, pg8::TileOrder, false, false>(F.lds, g, S, E);
}

constexpr int TB_OFF = 131072, TB_PRE = 24, TB_R6 = 64, TB_R7 = 384;
__device__ __forceinline__ void moe_tables(Frame& F) {
    LAS int* tb = (LAS int*)(F.lds + TB_OFF);
    __syncthreads();
    if (F.tid == 0) {
        int pre = 0;
        for (int k = 0; k < NBK; ++k) { const int c = (int)__hip_atomic_load((unsigned*)(F.ctl + CW_CNT + k), RLX_AGENT); tb[k] = c; tb[TB_PRE + k] = pre; pre += (c + 255) >> 8; }
        tb[TB_PRE + 24] = pre;
    }
    __syncthreads();
    const int np = tb[TB_PRE + 24];
    for (int q = F.tid; q < 2 * np; q += NTHR) {
        int bk = 0;
        for (int k = 1; k < NBK; ++k) if (q >= 2 * tb[TB_PRE + k]) bk = k;
        const int ntk = tb[TB_PRE + bk + 1] - tb[TB_PRE + bk]; const int r = q - 2 * tb[TB_PRE + bk]; const int x = r >= ntk ? 1 : 0; const int rt = r - x * ntk;
        tb[TB_R6 + q] = bk | (x << 8) | (rt << 16);
    }
    for (int q = F.tid; q < np; q += NTHR) {
        int bk = 0;
        for (int k = 1; k < NBK; ++k) if (q >= tb[TB_PRE + k]) bk = k;
        tb[TB_R7 + q] = bk | ((q - tb[TB_PRE + bk]) << 16);
    }
    __syncthreads();
}
struct MoeUpOrder {
    const LAS int* tb; int G, c; const char* hn2; const char* wg;
    __device__ __forceinline__ bool next(int i, pg8::GUnit& u) const {
        const int L = i * G + c; const int nq = 2 * tb[TB_PRE + 24]; if (L >= 4 * nq) return false;
        const int q = L >> 2, pn = L & 3; const int w = tb[TB_R6 + q]; const int bk = w & 255, x = (w >> 8) & 1, rt = w >> 16;
        int elo, ehi; bk_experts(bk, elo, ehi); const int e = x ? ehi : elo;
        u.A = hn2; u.B = wg + ((size_t)e * DE + pn * 128) * (DM * 2); u.B2 = nullptr;
        u.pm = bk * T; u.e0 = rt * 256; u.e1 = tb[bk] - rt * 256; u.pn = pn | (x << 8) | ((tb[TB_PRE + bk] + rt) << 16);
        return true;
    }
};
struct EpiGateUp {
    bf16* hid; const float* gpos;
    __device__ __forceinline__ void operator()(const f32x4 (&acc)[2][2][4][2], const pg8::GUnit& u, int wr, int wc, int fr, int fq) const {
        const int pn = u.pn & 255, x = (u.pn >> 8) & 1, trow = u.pn >> 16;
        const int col0 = x * 512 + pn * 128 + 32 * wc + 8 * fq;
#pragma unroll
        for (int ai = 0; ai < 2; ++ai)
#pragma unroll
            for (int m = 0; m < 4; ++m) {
                const int it = ai * 128 + wr * 64 + m * 16 + fr; const bool valid = it < u.e1;
                const float gate = valid ? gpos[((size_t)u.pm + u.e0 + it) * 2 + x] : 0.f;
                float hv[8];
#pragma unroll
                for (int n = 0; n < 2; ++n) { const f32x4 gv = acc[ai][0][m][n], uv = acc[ai][1][m][n];
                    hv[4 * n + 0] = gv.x * sigmoidf_(gv.x) * uv.x * gate; hv[4 * n + 1] = gv.y * sigmoidf_(gv.y) * uv.y * gate;
                    hv[4 * n + 2] = gv.z * sigmoidf_(gv.z) * uv.z * gate; hv[4 * n + 3] = gv.w * sigmoidf_(gv.w) * uv.w * gate; }
                v4u w; w.x = pg8::cvt_pk_bf16(hv[0], hv[1]); w.y = pg8::cvt_pk_bf16(hv[2], hv[3]); w.z = pg8::cvt_pk_bf16(hv[4], hv[5]); w.w = pg8::cvt_pk_bf16(hv[6], hv[7]);
                *(GAS v4u*)(hid + ((size_t)trow * 256 + it) * DM + col0) = w;
            }
    }
};
__device__ __forceinline__ void p6_fast(Frame& F, const Args& a) {
    moe_tables(F);
    pg8::GemmCfg g; g.nt = DM / 64; g.kseg = g.nt; g.lda = DM * 2; g.ldb = DM * 2; g.hstepA = 0; g.hstepB = (size_t)(WS_WU - WS_WG); g.bmap = pg8::MAP_P32; g.glist = (const int*)(F.ws + WS_LIST);
    MoeUpOrder S; S.tb = (const LAS int*)(F.lds + TB_OFF); S.G = F.G; S.c = F.vcu; S.hn2 = (const char*)(F.ws + WS_XN); S.wg = (const char*)(F.ws + WS_WG);
    EpiGateUp E; E.hid = (bf16*)(F.ws + WS_HID); E.gpos = (const float*)(F.ws + WS_GPOS);
    pg8::gemm_phase<EpiGateUp, MoeUpOrder, true, false>(F.lds, g, S, E);
}
struct MoeDownOrder {
    const LAS int* tb; int G, c; const char* hid; const char* wd;
    __device__ __forceinline__ bool next(int i, pg8::GUnit& u) const {
        const int L = i * G + c; const int nM = tb[TB_PRE + 24]; if (L >= 4 * nM) return false;
        const int nig = 32, gid = L / nig, fm = gid * 8, gsz = (nM - fm) < 8 ? (nM - fm) : 8;
        const int q = fm + ((L % nig) % gsz), pn = (L % nig) / gsz;
        const int w = tb[TB_R7 + q]; const int bk = w & 255, rt = w >> 16;
        int elo, ehi; bk_experts(bk, elo, ehi);
        u.A = hid + (size_t)q * 256 * (DM * 2); u.B = wd + ((size_t)elo * DM + pn * 256) * (DE * 2); u.B2 = wd + ((size_t)ehi * DM + pn * 256) * (DE * 2);
        u.pm = bk * T; u.e0 = rt * 256; u.e1 = tb[bk] - rt * 256; u.pn = pn;
        return true;
    }
};
struct EpiDown {
    float* out; const int* list;
    __device__ __forceinline__ void operator()(const f32x4 (&acc)[2][2][4][2], const pg8::GUnit& u, int wr, int wc, int fr, int fq) const {
        const int col0 = u.pn * 256 + wc * 32 + 4 * fq;
#pragma unroll
        for (int ai = 0; ai < 2; ++ai)
#pragma unroll
            for (int m = 0; m < 4; ++m) {
                const int it = ai * 128 + wr * 64 + m * 16 + fr;
                if (it < u.e1) {
                    const int tok = list[u.pm + u.e0 + it]; float* rowp = out + (size_t)tok * DM + col0;
#pragma unroll
                    for (int bj = 0; bj < 2; ++bj)
#pragma unroll
                        for (int n = 0; n < 2; ++n) { const f32x4 hv = *(const GAS f32x4*)(rowp + bj * 128 + n * 16); *(GAS f32x4*)(rowp + bj * 128 + n * 16) = hv + acc[ai][bj][m][n]; }
                }
                if (m & 1) asm volatile("" ::: "memory");
            }
    }
};
__device__ __forceinline__ void p7_fast(Frame& F, const Args& a) {
    moe_tables(F);
    pg8::GemmCfg g; g.nt = DM / 64; g.kseg = 8; g.lda = DM * 2; g.ldb = DE * 2; g.hstepA = (size_t)128 * DM * 2; g.hstepB = (size_t)128 * DE * 2; g.bmap = pg8::MAP_NAT; g.glist = nullptr;
    MoeDownOrder S; S.tb = (const LAS int*)(F.lds + TB_OFF); S.G = F.G; S.c = F.vcu; S.hid = (const char*)(F.ws + WS_HID); S.wd = (const char*)(F.ws + WS_WD);
    EpiDown E; E.out = F.out; E.list = (const int*)(F.ws + WS_LIST);
    pg8::gemm_phase<EpiDown, MoeDownOrder, false, true>(F.lds, g, S, E);
}

__global__ void __launch_bounds__(NTHR, 2) fwd_kernel(Args args) {
    extern __shared__ __attribute__((aligned(16))) unsigned char lds[];
    Frame F;
    F.lds = (LAS unsigned char*)lds;
    F.MISC = (volatile LAS unsigned*)(F.lds + MISC_OFF);
    F.retid();
    F.G = gridDim.x; { const int bx = blockIdx.x; F.vcu = (F.G % 8 == 0) ? (bx % 8) * (F.G / 8) + bx / 8 : bx; }
    F.ws = args.ws; F.out = args.out; F.ctl = (gu32*)(args.ws + WS_CTL);
    for (int u = F.tid; u < (LDS_BYTES - LDSCTL_OFF) / 4; u += NTHR) ((LAS unsigned*)(F.lds + LDSCTL_OFF))[u] = 0u;
    __syncthreads();
    XcdBarrier bar; bar.bar = (unsigned*)(F.ctl + CW_BAR); bar.x = 0; bar.st = nullptr;
    if (N_LAUNCHES != PER_PHASE) bar = xcd_barrier_post((unsigned*)(F.ctl + CW_BAR), F.MISC + 8);
#define GRID_BAR() do { if (N_LAUNCHES != PER_PHASE) xcd_barrier(bar); } while (0)
    const int lo = args.ph_lo, hi = args.ph_hi;
#define IN(k) (lo <= (k) && (k) < hi)
#define BOTH(k) (IN(k) && IN((k) + 1))
    if (IN(0)) { F.retid(); p0_prologue(F, args); if (BOTH(0)) GRID_BAR(); }
    if (IN(1)) { F.retid(); p1_fast(F, args); if (BOTH(1)) GRID_BAR(); }
    if (IN(2)) { F.retid(); for (int i = F.vcu; i < BATCH * 32; i += F.G) lru_chunk<false>(F, args, i >> 5, i & 31); if (BOTH(2)) GRID_BAR(); }
    if (IN(3)) { F.retid(); p3_fast(F, args); if (BOTH(3)) GRID_BAR(); }
    if (IN(4)) { F.retid(); p4_fast(F, args); if (BOTH(4)) GRID_BAR(); }
    if (IN(5)) { F.retid(); p5_route(F, args); if (BOTH(5)) GRID_BAR(); }
    if (IN(6)) { F.retid(); p6_fast(F, args); if (BOTH(6)) GRID_BAR(); }
    if (IN(7)) { F.retid(); p7_fast(F, args); }
#undef IN
#undef BOTH
}

extern "C" void kernel_launch(void* const* d_in, const int* in_sizes, int n_in, void* d_out, int out_size, void* d_ws, size_t ws_size, hipStream_t stream) {
    static int grid = 0;
    if (grid == 0) {
        if (n_in != 27 || in_sizes[0] != T * DM || out_size != T * DM || ws_size < WS_END) {
            fprintf(stderr, "kernel_launch: unexpected shapes (n_in %d, in0 %d, out %d, ws %zu); nothing launched\n", n_in, n_in > 0 ? in_sizes[0] : -1, out_size, ws_size); grid = -1; return; }
        int dev = 0, cus = 0;
        if (hipGetDevice(&dev) != hipSuccess || hipDeviceGetAttribute(&cus, hipDeviceAttributeMultiprocessorCount, dev) != hipSuccess) { grid = -1; return; }
        if (hipFuncSetAttribute((const void*)fwd_kernel, hipFuncAttributeMaxDynamicSharedMemorySize, LDS_BYTES) != hipSuccess) { fprintf(stderr, "kernel_launch: hipFuncSetAttribute failed\n"); grid = -1; return; }
        (void)hipGetLastError();
        grid = cus;
    }
    if (grid < 0) return;
    if (hipMemsetAsync((char*)d_ws + WS_CTL, 0, CTL_ZERO_BYTES, stream) != hipSuccess) return;
    Args a{};
    for (int i = 0; i < 27; ++i) a.in[i] = (const float*)d_in[i];
    a.out = (float*)d_out; a.ws = (unsigned char*)d_ws;
    for (int li = 0; li < N_LAUNCHES; ++li) {
        a.ph_lo = (N_LAUNCHES == PER_PHASE) ? li : 0; a.ph_hi = (N_LAUNCHES == PER_PHASE) ? li + 1 : PER_PHASE; a.li = li;
        hipLaunchKernelGGL(fwd_kernel, dim3(grid), dim3(NTHR), LDS_BYTES, stream, a);
    }
}
```

```cpp
#include <hip/hip_runtime.h>
#include <cstdio>
#include <cstdint>

#ifndef MK_N_LAUNCHES
#define MK_N_LAUNCHES 1
#endif
#ifndef PROBE_PHASE
#define PROBE_PHASE -1
#endif
constexpr int N_LAUNCHES = MK_N_LAUNCHES;
constexpr int PER_PHASE = 8;

#define GAS __attribute__((address_space(1)))
#define LAS __attribute__((address_space(3)))
typedef unsigned short bf16;
typedef unsigned v4u __attribute__((ext_vector_type(4)));
typedef unsigned v2u __attribute__((ext_vector_type(2)));
typedef float f32x4 __attribute__((ext_vector_type(4)));
typedef GAS unsigned gu32;
#define RLX_AGENT __ATOMIC_RELAXED, __HIP_MEMORY_SCOPE_AGENT
#define LDS_WAIT() asm volatile("s_waitcnt lgkmcnt(0)" ::: "memory")
#define VM_WAIT() asm volatile("s_waitcnt vmcnt(0)" ::: "memory")

constexpr int BATCH = 16, SEQ = 2048, DM = 1024, T = BATCH * SEQ;
constexpr int LW = 512, AW = 512, NH = 4, HD = 64, VD = 128, INC = 2560;
constexpr int NE = 16, DE = 512, NBK = 24;
constexpr float EPS = 1e-6f;
constexpr float LOG2E = 1.4426950408889634f;
constexpr float C2 = 0.125f * LOG2E;
constexpr int NWAVES = 8, NTHR = 512;

constexpr size_t MiB = 1u << 20;
constexpr size_t WS_CTL = 0, CTL_ZERO_BYTES = 1 * MiB;
constexpr size_t WS_WGATE = 1 * MiB;
constexpr size_t WS_WIN = 2 * MiB;
constexpr size_t WS_WOUT = 8 * MiB;
constexpr size_t WS_WG = 10 * MiB;
constexpr size_t WS_WU = 26 * MiB;
constexpr size_t WS_WD = 42 * MiB;
constexpr size_t WS_AGG = 58 * MiB;
constexpr size_t WS_GATES = 60 * MiB;
constexpr size_t WS_LIST = 61 * MiB;
constexpr size_t WS_XN = 64 * MiB;
constexpr size_t WS_XL = 128 * MiB;
constexpr size_t WS_GL = 160 * MiB;
constexpr size_t WS_Q = 192 * MiB;
constexpr size_t WS_K = 224 * MiB;
constexpr size_t WS_V = 256 * MiB;
constexpr size_t WS_Y = 288 * MiB;
constexpr size_t WS_HID = 128 * MiB;
constexpr int HID_ROWS = T + NBK * 256;
constexpr size_t WS_GPOS = 352 * MiB;
constexpr size_t WS_END = 360 * MiB;
static_assert(WS_HID + (size_t)HID_ROWS * 2048 <= WS_K, "hid overlay");
constexpr int CW_TMO = 0, CW_BAR = 4096, CW_CNT = 16384;

constexpr int SCR_BYTES = 143360;
constexpr int LDSCTL_OFF = SCR_BYTES, MISC_OFF = LDSCTL_OFF + 320;
constexpr int LDS_BYTES = 147456;

__device__ __forceinline__ unsigned f2bf(float f) { unsigned u = __builtin_bit_cast(unsigned, f); return (u + 0x7fffu + ((u >> 16) & 1u)) >> 16; }
__device__ __forceinline__ unsigned pk2(float lo, float hi) { return f2bf(lo) | (f2bf(hi) << 16); }
__device__ __forceinline__ float bf2f(bf16 b) { return __builtin_bit_cast(float, (unsigned)b << 16); }
__device__ __forceinline__ float bflo(unsigned w) { return __builtin_bit_cast(float, w << 16); }
__device__ __forceinline__ float bfhi(unsigned w) { return __builtin_bit_cast(float, w & 0xffff0000u); }
__device__ __forceinline__ float wave_sum(float v) {
#pragma unroll
    for (int o = 1; o < 64; o <<= 1) v += __shfl_xor(v, o);
    return v;
}
__device__ __forceinline__ int opaque_tid() { int t = threadIdx.x; asm volatile("" : "+v"(t)); return t; }
__device__ __forceinline__ float sigmoidf_(float x) { return 1.0f / (1.0f + __expf(-x)); }
__device__ __forceinline__ float gelu_tanh(float x) {
    const float z = 0.7978845608028654f * (x + 0.044715f * x * x * x);
    const float e = __expf(2.0f * z);
    const float th = 1.0f - 2.0f / (e + 1.0f);
    return 0.5f * x * (1.0f + th);
}

#define XB_TMO      128
#define XB_XCNT(j)  (256  + 64 * (j))
#define XB_XSUB(j)  (1280 + 64 * (j))
#define XB_XGEN(j)  (2304 + 64 * (j))
#define XB_TOP      3328
#define XB_TOPGEN   3392
#define XCD_BAR_WORDS 3456
#define XB_SPIN_CAP (1u << 18)
__device__ __forceinline__ unsigned xb_ld(unsigned* p)              { return __hip_atomic_load(p, __ATOMIC_RELAXED, __HIP_MEMORY_SCOPE_AGENT); }
__device__ __forceinline__ unsigned xb_add(unsigned* p, unsigned v) { return __hip_atomic_fetch_add(p, v, __ATOMIC_RELAXED, __HIP_MEMORY_SCOPE_AGENT); }
__device__ __forceinline__ unsigned xb_xcc_id() { return (unsigned)__builtin_amdgcn_s_getreg((3 << 11) | 20) & 0xFu; }
#define XB_SPIN(cond, bar) do { unsigned _sp = 0; while (cond) { __builtin_amdgcn_s_sleep(1); \
    if ((++_sp & 255u) == 0u) { if (xb_ld(&(bar)[XB_TMO])) break; if (_sp > XB_SPIN_CAP) { atomicAdd(&(bar)[XB_TMO], 1u); break; } } } } while (0)
struct XcdBarrier { unsigned* bar; unsigned x; volatile LAS unsigned* st; };
__device__ __forceinline__ XcdBarrier xcd_barrier_post(unsigned* bar, volatile LAS unsigned* st) {
    XcdBarrier b; b.bar = bar; b.x = xb_xcc_id(); b.st = st;
    if (threadIdx.x == 0) (void)xb_add(&bar[XB_XCNT(b.x)], 1u);
    return b;
}
__device__ __forceinline__ void xcd_barrier_complete(unsigned* bar, unsigned x, unsigned& nloc, unsigned& nx) {
    const unsigned G = gridDim.x * gridDim.y * gridDim.z;
    unsigned sum, cnt, mine, sp = 0u;
    for (;;) {
        sum = 0u; cnt = 0u; mine = 0u;
#pragma unroll
        for (unsigned j = 0; j < 16; ++j) { const unsigned c = xb_ld(&bar[XB_XCNT(j)]); sum += c; cnt += (c > 0u) ? 1u : 0u; mine = (j == x) ? c : mine; }
        if (sum == G) break;
        __builtin_amdgcn_s_sleep(1);
        if ((++sp & 255u) == 0u) { if (xb_ld(&bar[XB_TMO])) break; if (sp > XB_SPIN_CAP) { atomicAdd(&bar[XB_TMO], 1u); break; } }
    }
    nloc = mine > 0u ? mine : 1u; nx = cnt > 0u ? cnt : 1u;
}
__device__ __forceinline__ void xcd_barrier(const XcdBarrier& b) {
    asm volatile("s_waitcnt vmcnt(0)" ::: "memory");
    __syncthreads();
    if (threadIdx.x == 0) {
        unsigned* bar = b.bar;
        __builtin_amdgcn_s_waitcnt(0);
        unsigned nloc = b.st[0], nx = b.st[1];
        if (nloc == 0u) { xcd_barrier_complete(bar, b.x, nloc, nx); b.st[0] = nloc; b.st[1] = nx; }
        const unsigned old = xb_add(&bar[XB_XSUB(b.x)], 1u);
        const unsigned gen = old / nloc;
        if (old + 1u == (gen + 1u) * nloc) {
            __builtin_amdgcn_fence(__ATOMIC_RELEASE, "agent");
            asm volatile("s_waitcnt vmcnt(0)" ::: "memory");
            const unsigned og = xb_add(&bar[XB_TOP], 1u);
            const unsigned tg = og / nx;
            if (og + 1u == (tg + 1u) * nx) xb_add(&bar[XB_TOPGEN], 1u);
            else XB_SPIN(xb_ld(&bar[XB_TOPGEN]) == tg, bar);
            __builtin_amdgcn_fence(__ATOMIC_ACQUIRE, "agent");
            xb_add(&bar[XB_XGEN(b.x)], 1u);
            asm volatile("s_waitcnt vmcnt(0)" ::: "memory");
        } else {
            XB_SPIN(xb_ld(&bar[XB_XGEN(b.x)]) == gen, bar);
            __builtin_amdgcn_fence(__ATOMIC_ACQUIRE, "agent");
            asm volatile("s_waitcnt vmcnt(0)" ::: "memory");
        }
    }
    __syncthreads();
}

struct Args { const float* in[27]; float* out; unsigned char* ws; int ph_lo, ph_hi, li, pad; };
struct Frame {
    LAS unsigned char* lds; volatile LAS unsigned* MISC; gu32* ctl;
    int tid, lane, wave, vcu, G;
    unsigned char* ws; float* out;
    __device__ __forceinline__ void retid() { tid = opaque_tid(); lane = tid & 63; wave = __builtin_amdgcn_readfirstlane(tid >> 6); }
};

__device__ __forceinline__ void p0_transpose_item(const float* W, int K, int N, bf16* WT, LAS float* scr, int item, int lane) {
    const int nblk = N / 32, kb = item / nblk, nb = item % nblk, k0 = 64 * kb, n0 = 32 * nb;
#pragma unroll 8
    for (int i = 0; i < 32; ++i) { const int kk = 2 * i + (lane >> 5); scr[kk * 33 + (lane & 31)] = W[(size_t)(k0 + kk) * N + n0 + (lane & 31)]; }
    LDS_WAIT(); asm volatile("" ::: "memory");
    const int c = lane & 7;
#pragma unroll
    for (int j = 0; j < 4; ++j) { const int n = (lane >> 3) + 8 * j; const LAS float* s = scr + (8 * c) * 33 + n;
        v4u o; o.x = pk2(s[0 * 33], s[1 * 33]); o.y = pk2(s[2 * 33], s[3 * 33]); o.z = pk2(s[4 * 33], s[5 * 33]); o.w = pk2(s[6 * 33], s[7 * 33]);
        *(GAS v4u*)(WT + (size_t)(n0 + n) * K + k0 + 8 * c) = o; }
    LDS_WAIT(); asm volatile("" ::: "memory");
}
__device__ __forceinline__ void rms_row_to_bf16(const float* xrow, const float* g, bf16* orow, int lane) {
    const GAS f32x4* xr = (const GAS f32x4*)xrow + lane;
    const GAS f32x4* gr = (const GAS f32x4*)g + lane;
    f32x4 v[4]; float s = 0.f;
#pragma unroll
    for (int j = 0; j < 4; ++j) { v[j] = xr[64 * j]; s += (v[j].x * v[j].x + v[j].y * v[j].y) + (v[j].z * v[j].z + v[j].w * v[j].w); }
    const float r = 1.0f / sqrtf(wave_sum(s) * (1.0f / DM) + EPS);
    GAS v2u* o8 = (GAS v2u*)orow + lane;
#pragma unroll
    for (int j = 0; j < 4; ++j) { const f32x4 gg = gr[64 * j]; v2u w; w.x = pk2(v[j].x * r * gg.x, v[j].y * r * gg.y); w.y = pk2(v[j].z * r * gg.z, v[j].w * r * gg.w); o8[64 * j] = w; }
}
__device__ __forceinline__ void p0_prologue(Frame& F, const Args& a) {
    LAS float* scr = (LAS float*)(F.lds + F.wave * 16384);
    const int gw = F.vcu * NWAVES + F.wave, NGW = F.G * NWAVES;
    constexpr int I_IN = (DM / 64) * (INC / 32), I_OUT = (DM / 64) * (DM / 32), I_E = 256;
    constexpr int NITEMS = I_IN + I_OUT + 3 * NE * I_E;
    bf16* Win_t = (bf16*)(F.ws + WS_WIN); bf16* Wout_t = (bf16*)(F.ws + WS_WOUT);
    bf16* Wg_t = (bf16*)(F.ws + WS_WG); bf16* Wu_t = (bf16*)(F.ws + WS_WU); bf16* Wd_t = (bf16*)(F.ws + WS_WD);
    for (int it = gw; it < NITEMS; it += NGW) {
        int r = it;
        if (r < I_IN) { p0_transpose_item(a.in[2], DM, INC, Win_t, scr, r, F.lane); continue; } r -= I_IN;
        if (r < I_OUT) { p0_transpose_item(a.in[18], DM, DM, Wout_t, scr, r, F.lane); continue; } r -= I_OUT;
        if (r < NE * I_E) { const int e = r / I_E; p0_transpose_item(a.in[24] + (size_t)e * DM * DE, DM, DE, Wg_t + (size_t)e * DE * DM, scr, r % I_E, F.lane); continue; } r -= NE * I_E;
        if (r < NE * I_E) { const int e = r / I_E; p0_transpose_item(a.in[25] + (size_t)e * DM * DE, DM, DE, Wu_t + (size_t)e * DE * DM, scr, r % I_E, F.lane); continue; } r -= NE * I_E;
        { const int e = r / I_E; p0_transpose_item(a.in[26] + (size_t)e * DE * DM, DE, DM, Wd_t + (size_t)e * DM * DE, scr, r % I_E, F.lane); }
    }
    {
        bf16* Wgt = (bf16*)(F.ws + WS_WGATE);
        for (int i = (F.vcu * NTHR + F.tid); i < 2 * 8 * 64 * 64; i += F.G * NTHR) {
            const int gsel = i >> 15, blk = (i >> 12) & 7, d = (i >> 6) & 63, c = i & 63;
            Wgt[i] = (bf16)f2bf(a.in[gsel ? 7 : 5][blk * 4096 + c * 64 + d]);
        }
    }
    bf16* XN = (bf16*)(F.ws + WS_XN);
    for (int m = gw; m < T; m += NGW) rms_row_to_bf16(a.in[0] + (size_t)m * DM, a.in[1], XN + (size_t)m * DM, F.lane);
}

template <class AF, class BF>
__device__ __forceinline__ void ngemm_acc(LAS float* As, LAS float* Bs, int K, AF arow, BF bcol, float (&acc)[8]) {
    const int tid = threadIdx.x, r = tid >> 3, cg = tid & 7;
    const bf16* ap = arow(r); const bf16* bp = bcol(r);
    for (int k0 = 0; k0 < K; k0 += 64) {
        __syncthreads();
        const v4u va = *(const GAS v4u*)(ap + k0 + cg * 8);
        const v4u vb = *(const GAS v4u*)(bp + k0 + cg * 8);
#pragma unroll
        for (int j = 0; j < 4; ++j) {
            As[r * 65 + cg * 8 + 2 * j] = bflo(va[j]); As[r * 65 + cg * 8 + 2 * j + 1] = bfhi(va[j]);
            Bs[(cg * 8 + 2 * j) * 72 + r] = bflo(vb[j]); Bs[(cg * 8 + 2 * j + 1) * 72 + r] = bfhi(vb[j]);
        }
        __syncthreads();
#pragma unroll 8
        for (int kk = 0; kk < 64; ++kk) {
            const float av = As[r * 65 + kk];
            const f32x4 b0 = *(const LAS f32x4*)&Bs[kk * 72 + cg * 8], b1 = *(const LAS f32x4*)&Bs[kk * 72 + cg * 8 + 4];
            acc[0] += av * b0.x; acc[1] += av * b0.y; acc[2] += av * b0.z; acc[3] += av * b0.w;
            acc[4] += av * b1.x; acc[5] += av * b1.y; acc[6] += av * b1.z; acc[7] += av * b1.w;
        }
    }
}
__device__ __forceinline__ v4u pack8(const float (&v)[8]) { v4u o; o.x = pk2(v[0], v[1]); o.y = pk2(v[2], v[3]); o.z = pk2(v[4], v[5]); o.w = pk2(v[6], v[7]); return o; }
__device__ __forceinline__ float sum8lanes(float v) { v += __shfl_xor(v, 1); v += __shfl_xor(v, 2); v += __shfl_xor(v, 4); return v; }
__device__ __forceinline__ float max8lanes(float v) { v = fmaxf(v, __shfl_xor(v, 1)); v = fmaxf(v, __shfl_xor(v, 2)); v = fmaxf(v, __shfl_xor(v, 4)); return v; }

__device__ __forceinline__ void p1_simple(Frame& F, const Args& a) {
    LAS float* As = (LAS float*)F.lds; LAS float* Bs = As + 64 * 65;
    const bf16* XN = (const bf16*)(F.ws + WS_XN); const bf16* Win_t = (const bf16*)(F.ws + WS_WIN);
    const int tid = F.tid, r = tid >> 3, cg = tid & 7;
    constexpr int NCT = INC / 64;
    for (int tt = F.vcu; tt < (T / 64) * NCT; tt += F.G) {
        const int rt = tt / NCT, ct = tt % NCT;
        float acc[8] = {0.f, 0.f, 0.f, 0.f, 0.f, 0.f, 0.f, 0.f};
        ngemm_acc(As, Bs, DM, [&](int rr) { return XN + (size_t)(rt * 64 + rr) * DM; }, [&](int cc) { return Win_t + (size_t)(ct * 64 + cc) * DM; }, acc);
        const int region = ct >> 3, lc0 = (ct & 7) * 64 + cg * 8; const size_t row = (size_t)rt * 64 + r;
        bf16* dst = (bf16*)(F.ws + WS_XL + (size_t)region * 32 * MiB) + row * 512 + lc0;
        if (region == 1) {
#pragma unroll
            for (int j = 0; j < 8; ++j) acc[j] = gelu_tanh(acc[j]);
        } else if (region == 2 || region == 3) {
            float ss = 0.f;
#pragma unroll
            for (int j = 0; j < 8; ++j) ss += acc[j] * acc[j];
            ss = sum8lanes(ss);
            const float rr = (1.0f / sqrtf(ss * (1.0f / HD) + EPS)) * (region == 2 ? C2 : 1.0f);
            const float* g = a.in[region == 2 ? 11 : 12] + cg * 8;
#pragma unroll
            for (int j = 0; j < 8; ++j) acc[j] = acc[j] * rr * g[j];
        }
        *(GAS v4u*)dst = pack8(acc);
    }
}


namespace pg8 {
typedef short bf16x8 __attribute__((ext_vector_type(8)));
constexpr int BM = 256, BK = 64, HALF = 128, HTB = HALF * BK * 2, STAGE_BYTES = 8 * HTB;
__host__ __device__ __forceinline__ int lds_byte(int r, int c) { const int st = (r >> 4) * 2 + (c >> 5), rr = r & 15, cc = c & 31, ob = rr * 64 + cc * 2; return st * 1024 + (ob ^ (((ob >> 9) & 1) << 5)); }
__host__ __device__ __forceinline__ void stage_rc(int b, int& R, int& C) { const int st = b / 1024, sb = b % 1024, swz = sb ^ (((sb >> 9) & 1) << 5); R = (st >> 1) * 16 + swz / 64; C = (st & 1) * 32 + (swz % 64) / 2; }
__host__ __device__ __forceinline__ int perm32(int rho) { const int n = rho >> 4, i = rho & 15; return 8 * (i >> 2) + 4 * n + (i & 3); }
enum { MAP_NAT = 0, MAP_P32 = 1, MAP_G64 = 2 };
__device__ __forceinline__ int bmap_row(int map, int R) { return map == MAP_NAT ? R : (map == MAP_P32 ? 32 * (R >> 5) + perm32(R & 31) : 64 * (R >> 5) + perm32(R & 31)); }

struct GUnit { const char* A; const char* B; const char* B2; int pm, pn, e0, e1; };

struct GemmCfg { int nt, kseg; unsigned lda, ldb; size_t hstepA, hstepB; int bmap; const int* glist; };

template <class Epi, class Sched, bool GATHER, bool SEGB>
__device__ __forceinline__ void gemm_phase(LAS unsigned char* lds, const GemmCfg g, const Sched& S, const Epi& E) {
    const int tid = opaque_tid(), wid = __builtin_amdgcn_readfirstlane(tid >> 6), lane = tid & 63, wr = wid >> 2, wc = wid & 3, fr = lane & 15, fq = lane >> 4;
    const int nt = g.nt;
    unsigned voffA[2], voffB[2]; int RA[2];
#pragma unroll
    for (int i = 0; i < 2; ++i) { int R, C; stage_rc(tid * 16 + i * 8192, R, C); RA[i] = R;
        voffA[i] = GATHER ? (unsigned)(C * 2) : (unsigned)R * g.lda + (unsigned)(C * 2); voffB[i] = (unsigned)bmap_row(g.bmap, R) * g.ldb + (unsigned)(C * 2); }
    const size_t kstep = (size_t)(BK * 2);
    const size_t hstepA = g.hstepA, hstepB = g.hstepB;
    const unsigned ldsw = (unsigned)wid * 1024u;
    const int aoff = lds_byte(wr * 64 + fr, fq * 8), boff = lds_byte(wc * 32 + fr, fq * 8);
#define PG8_SA(b, h) (((b) * 2 + (h)) * HTB)
#define PG8_SB(b, h) ((4 + (b) * 2 + (h)) * HTB)
#define PG8_STAGE(bufoff, gbase, voff) do { _Pragma("unroll") for (int _i = 0; _i < 2; ++_i) \
        __builtin_amdgcn_global_load_lds((const unsigned*)((const char*)(gbase) + (voff)[_i]), (LAS unsigned*)(lds + (bufoff) + ldsw + _i * 8192), 16, 0, 0); } while (0)
#define PG8_LDA(dst, b, h) do { _Pragma("unroll") for (int m = 0; m < 4; ++m) _Pragma("unroll") for (int k = 0; k < 2; ++k) dst[m][k] = *(const LAS bf16x8*)(lds + PG8_SA(b, h) + aoff + m * 2048 + k * 1024); } while (0)
#define PG8_LDB(dst, b, h) do { _Pragma("unroll") for (int n = 0; n < 2; ++n) _Pragma("unroll") for (int k = 0; k < 2; ++k) dst[n][k] = *(const LAS bf16x8*)(lds + PG8_SB(b, h) + boff + n * 2048 + k * 1024); } while (0)
#define PG8_MMA(ai, bj, At, Bt) do { __builtin_amdgcn_s_setprio(1); _Pragma("unroll") for (int m = 0; m < 4; ++m) _Pragma("unroll") for (int n = 0; n < 2; ++n) _Pragma("unroll") for (int k = 0; k < 2; ++k) \
        acc[ai][bj][m][n] = __builtin_amdgcn_mfma_f32_16x16x32_bf16(Bt[n][k], At[m][k], acc[ai][bj][m][n], 0, 0, 0); __builtin_amdgcn_s_setprio(0); } while (0)
#define PG8_WAIT_V(n) asm volatile("s_waitcnt vmcnt(" #n ")" ::: "memory")
#define PG8_WAIT_L(n) asm volatile("s_waitcnt lgkmcnt(" #n ")" ::: "memory")
#define PG8_BAR __builtin_amdgcn_s_barrier()
#define PG8_SCHED __builtin_amdgcn_sched_barrier(0)
    GUnit cur, nxt; int ui = 0;
    if (!S.next(0, cur)) return;
    f32x4 acc[2][2][4][2];
#pragma unroll
    for (int a = 0; a < 2; ++a)
#pragma unroll
        for (int b = 0; b < 2; ++b)
#pragma unroll
            for (int m = 0; m < 4; ++m)
#pragma unroll
                for (int n = 0; n < 2; ++n) acc[a][b][m][n] = (f32x4){0.f, 0.f, 0.f, 0.f};
    bf16x8 At[4][2], B0[2][2], B1[2][2];
    unsigned vg0[2], vg1[2];
    auto load_gather = [&](const GUnit& u, unsigned (&o0)[2], unsigned (&o1)[2]) {
#pragma unroll
        for (int i = 0; i < 2; ++i) {
            const int r0 = RA[i], r1 = 128 + RA[i];
            const int t0 = g.glist[u.pm + (r0 < u.e1 ? u.e0 + r0 : 0)], t1 = g.glist[u.pm + (r1 < u.e1 ? u.e0 + r1 : 0)];
            o0[i] = (unsigned)t0 * g.lda + voffA[i]; o1[i] = (unsigned)t1 * g.lda + voffA[i];
        }
    };
    const char* cA = cur.A; const char* cB = cur.B; const char* cB2 = cur.B2;
    if constexpr (GATHER) load_gather(cur, vg0, vg1);
#define PG8_A0(base, kt) (GATHER ? (base) + (size_t)(kt) * kstep : (base) + (size_t)(kt) * kstep)
#define PG8_STAGE_A0(bufoff, base, kt) do { if constexpr (GATHER) PG8_STAGE(bufoff, (base) + (size_t)(kt) * kstep, vg0); else PG8_STAGE(bufoff, (base) + (size_t)(kt) * kstep, voffA); } while (0)
#define PG8_STAGE_A1(bufoff, base, kt) do { if constexpr (GATHER) PG8_STAGE(bufoff, (base) + (size_t)(kt) * kstep, vg1); else PG8_STAGE(bufoff, (base) + hstepA + (size_t)(kt) * kstep, voffA); } while (0)
#define PG8_BP(B_, B2_, kt) ((SEGB && (kt) >= g.kseg) ? (B2_) + (size_t)((kt) - g.kseg) * kstep : (B_) + (size_t)(kt) * kstep)
    PG8_STAGE(PG8_SB(0, 0), cB, voffB); PG8_STAGE(PG8_SB(0, 1), cB + hstepB, voffB); PG8_STAGE_A0(PG8_SA(0, 0), cA, 0); PG8_STAGE_A1(PG8_SA(0, 1), cA, 0);
    if (wr == 1) PG8_BAR;
    PG8_WAIT_V(2); PG8_BAR;
    PG8_STAGE(PG8_SB(1, 0), cB + kstep, voffB); PG8_STAGE_A0(PG8_SA(1, 0), cA, 1); PG8_STAGE(PG8_SB(1, 1), cB + hstepB + kstep, voffB);
    PG8_WAIT_V(6); PG8_BAR;
    for (;;) {
        const bool has_next = S.next(ui + 1, nxt);
        const char* nA = has_next ? nxt.A : cA; const char* nB = has_next ? nxt.B : cB; const char* nB2 = has_next ? nxt.B2 : cB2;
        for (int t = 0; t < nt; t += 2) {
            const bool last = (t == nt - 2);
            unsigned ng0[2], ng1[2];
            if constexpr (GATHER) { if (last) { if (has_next) load_gather(nxt, ng0, ng1); else { ng0[0] = vg0[0]; ng0[1] = vg0[1]; ng1[0] = vg1[0]; ng1[1] = vg1[1]; } } }
            const char* b2 = last ? PG8_BP(nB, nB2, 0) : PG8_BP(cB, cB2, t + 2);
            const char* b3 = last ? PG8_BP(nB, nB2, 1) : PG8_BP(cB, cB2, t + 3);
            const char* a23 = last ? nA : cA; const int k2 = last ? 0 : t + 2, k3 = last ? 1 : t + 3;
            PG8_LDB(B0, 0, 0); PG8_LDB(B1, 0, 1); PG8_SCHED; PG8_LDA(At, 0, 0); PG8_STAGE_A1(PG8_SA(1, 1), cA, t + 1);
            PG8_WAIT_V(8); PG8_WAIT_L(0); PG8_BAR; PG8_MMA(0, 0, At, B0); PG8_MMA(0, 1, At, B1); PG8_BAR; PG8_SCHED;
            if constexpr (GATHER) { if (last) { vg0[0] = ng0[0]; vg0[1] = ng0[1]; vg1[0] = ng1[0]; vg1[1] = ng1[1]; } }
            PG8_LDA(At, 0, 1); PG8_STAGE(PG8_SB(0, 0), b2, voffB); PG8_STAGE(PG8_SB(0, 1), b2 + hstepB, voffB); PG8_STAGE_A0(PG8_SA(0, 0), a23, k2);
            PG8_WAIT_V(8); PG8_WAIT_L(0); PG8_BAR; PG8_MMA(1, 0, At, B0); PG8_MMA(1, 1, At, B1); PG8_BAR; PG8_SCHED;
            PG8_LDB(B0, 1, 0); PG8_LDB(B1, 1, 1); PG8_SCHED; PG8_LDA(At, 1, 0); PG8_STAGE_A1(PG8_SA(0, 1), a23, k2);
            PG8_WAIT_V(8); PG8_WAIT_L(0); PG8_BAR; PG8_MMA(0, 0, At, B0); PG8_MMA(0, 1, At, B1); PG8_BAR; PG8_SCHED;
            PG8_LDA(At, 1, 1); PG8_STAGE(PG8_SB(1, 0), b3, voffB); PG8_STAGE(PG8_SB(1, 1), b3 + hstepB, voffB); PG8_STAGE_A0(PG8_SA(1, 0), a23, k3);
            PG8_WAIT_V(8); PG8_WAIT_L(0); PG8_BAR; PG8_MMA(1, 0, At, B0); PG8_MMA(1, 1, At, B1); PG8_BAR; PG8_SCHED;
        }
        if (wr == 0) PG8_BAR;
        E(acc, cur, wr, wc, fr, fq);
        if (!has_next) break;
#pragma unroll
        for (int a = 0; a < 2; ++a)
#pragma unroll
            for (int b = 0; b < 2; ++b)
#pragma unroll
                for (int m = 0; m < 4; ++m)
#pragma unroll
                    for (int n = 0; n < 2; ++n) acc[a][b][m][n] = (f32x4){0.f, 0.f, 0.f, 0.f};
        cur = nxt; cA = nA; cB = nB; cB2 = nB2; ++ui;
        if (wr == 1) PG8_BAR;
    }
    PG8_WAIT_V(0);
    PG8_BAR;
#undef PG8_SA
#undef PG8_SB
#undef PG8_STAGE
#undef PG8_LDA
#undef PG8_LDB
#undef PG8_MMA
#undef PG8_WAIT_V
#undef PG8_WAIT_L
#undef PG8_BAR
#undef PG8_SCHED
#undef PG8_A0
#undef PG8_STAGE_A0
#undef PG8_STAGE_A1
#undef PG8_BP
}
struct TileOrder {
    int nM, nN, G, c; const char* A; const char* B; size_t tstepA, tstepB;
    __device__ __forceinline__ bool next(int i, GUnit& u) const {
        const int L = i * G + c; if (L >= nM * nN) return false;
        const int nig = 8 * nN, gid = L / nig, fm = gid * 8, gsz = (nM - fm) < 8 ? (nM - fm) : 8;
        u.pm = fm + ((L % nig) % gsz); u.pn = (L % nig) / gsz; u.A = A + (size_t)u.pm * tstepA; u.B = B + (size_t)u.pn * tstepB; u.B2 = nullptr; u.e0 = 0; u.e1 = 0; return true;
    }
};
__device__ __forceinline__ unsigned cvt_pk_bf16(float lo, float hi) { unsigned r; asm volatile("v_cvt_pk_bf16_f32 %0, %1, %2" : "=v"(r) : "v"(lo), "v"(hi)); return r; }
}

struct EpiProj {
    unsigned char* ws; const float* qg; const float* kg;
    __device__ __forceinline__ void operator()(const f32x4 (&acc)[2][2][4][2], const pg8::GUnit& u, int wr, int wc, int fr, int fq) const {
        const int region = u.pn >> 1, lc0 = (u.pn & 1) * 256 + 64 * wc + 8 * fq;
        bf16* base = (bf16*)(ws + WS_XL + (size_t)region * 32 * MiB);
        f32x4 gv[2][2];
        if (region == 2 || region == 3) {
            const float* g = (region == 2 ? qg : kg) + 8 * fq;
#pragma unroll
            for (int bj = 0; bj < 2; ++bj)
#pragma unroll
                for (int n = 0; n < 2; ++n) gv[bj][n] = *(const GAS f32x4*)(g + 32 * bj + 4 * n);
        }
#pragma unroll
        for (int ai = 0; ai < 2; ++ai)
#pragma unroll
            for (int m = 0; m < 4; ++m) {
                const size_t row = (size_t)u.pm * 256 + ai * 128 + wr * 64 + m * 16 + fr;
                f32x4 v[2][2];
#pragma unroll
                for (int bj = 0; bj < 2; ++bj)
#pragma unroll
                    for (int n = 0; n < 2; ++n) v[bj][n] = acc[ai][bj][m][n];
                if (region == 1) {
#pragma unroll
                    for (int bj = 0; bj < 2; ++bj)
#pragma unroll
                        for (int n = 0; n < 2; ++n) { v[bj][n].x = gelu_tanh(v[bj][n].x); v[bj][n].y = gelu_tanh(v[bj][n].y); v[bj][n].z = gelu_tanh(v[bj][n].z); v[bj][n].w = gelu_tanh(v[bj][n].w); }
                } else if (region == 2 || region == 3) {
                    float ss = 0.f;
#pragma unroll
                    for (int bj = 0; bj < 2; ++bj)
#pragma unroll
                        for (int n = 0; n < 2; ++n) ss += (v[bj][n].x * v[bj][n].x + v[bj][n].y * v[bj][n].y) + (v[bj][n].z * v[bj][n].z + v[bj][n].w * v[bj][n].w);
                    ss += __shfl_xor(ss, 16); ss += __shfl_xor(ss, 32);
                    const float rr = (1.0f / sqrtf(ss * (1.0f / HD) + EPS)) * (region == 2 ? C2 : 1.0f);
#pragma unroll
                    for (int bj = 0; bj < 2; ++bj)
#pragma unroll
                        for (int n = 0; n < 2; ++n) v[bj][n] = v[bj][n] * rr * gv[bj][n];
                }
                bf16* rowp = base + row * 512 + lc0;
#pragma unroll
                for (int bj = 0; bj < 2; ++bj) { v4u w; w.x = pg8::cvt_pk_bf16(v[bj][0].x, v[bj][0].y); w.y = pg8::cvt_pk_bf16(v[bj][0].z, v[bj][0].w); w.z = pg8::cvt_pk_bf16(v[bj][1].x, v[bj][1].y); w.w = pg8::cvt_pk_bf16(v[bj][1].z, v[bj][1].w);
                    *(GAS v4u*)(rowp + 32 * bj) = w; }
            }
    }
};
__device__ __forceinline__ void p1_fast(Frame& F, const Args& a) {
    pg8::GemmCfg g; g.nt = DM / 64; g.kseg = g.nt; g.lda = DM * 2; g.ldb = DM * 2; g.hstepA = (size_t)128 * DM * 2; g.hstepB = (size_t)32 * DM * 2; g.bmap = pg8::MAP_G64; g.glist = nullptr;
    pg8::TileOrder S; S.nM = T / 256; S.nN = INC / 256; S.G = F.G; S.c = F.vcu; S.A = (const char*)(F.ws + WS_XN); S.B = (const char*)(F.ws + WS_WIN); S.tstepA = (size_t)256 * DM * 2; S.tstepB = (size_t)256 * DM * 2;
    EpiProj E; E.ws = F.ws; E.qg = a.in[11]; E.kg = a.in[12];
    pg8::gemm_phase<EpiProj, pg8::TileOrder, false, false>(F.lds, g, S, E);
}

template <bool APPLY>
__device__ __forceinline__ void lru_chunk(Frame& F, const Args& a, int b, int j) {
    LAS float* XC = (LAS float*)F.lds;
    const int ch = F.tid; const size_t row0 = (size_t)b * SEQ + (size_t)j * 64;
    const bf16* XL = (const bf16*)(F.ws + WS_XL); const bf16* GL = (const bf16*)(F.ws + WS_GL);
    float* AGG = (float*)(F.ws + WS_AGG);
    __syncthreads();
    {
        const float cw0 = a.in[3][ch], cw1 = a.in[3][512 + ch], cw2 = a.in[3][1024 + ch], cw3 = a.in[3][1536 + ch], cb = a.in[4][ch];
        float x0 = 0.f, x1 = 0.f, x2 = 0.f;
        if (j > 0) { x0 = bf2f(XL[(row0 - 3) * 512 + ch]); x1 = bf2f(XL[(row0 - 2) * 512 + ch]); x2 = bf2f(XL[(row0 - 1) * 512 + ch]); }
#pragma unroll 8
        for (int t = 0; t < 64; ++t) {
            const float x3 = bf2f(XL[(row0 + t) * 512 + ch]);
            XC[t * 512 + ch] = cb + cw0 * x0 + cw1 * x1 + cw2 * x2 + cw3 * x3;
            x0 = x1; x1 = x2; x2 = x3;
        }
    }
    __syncthreads();
    float ra[64], ri[64];
#pragma unroll
    for (int t = 0; t < 64; ++t) { ra[t] = 0.f; ri[t] = 0.f; }
    {
        const int blk = ch >> 6, d = ch & 63;
        const float* Wa = a.in[5] + blk * 4096 + d; const float* Wx = a.in[7] + blk * 4096 + d;
        const LAS float* xb = XC + blk * 64;
#pragma unroll 1
        for (int c = 0; c < 64; c += 4) {
            const float wa0 = Wa[(c + 0) * 64], wa1 = Wa[(c + 1) * 64], wa2 = Wa[(c + 2) * 64], wa3 = Wa[(c + 3) * 64];
            const float wx0 = Wx[(c + 0) * 64], wx1 = Wx[(c + 1) * 64], wx2 = Wx[(c + 2) * 64], wx3 = Wx[(c + 3) * 64];
#pragma unroll
            for (int t = 0; t < 64; ++t) {
                const f32x4 xv = *(const LAS f32x4*)&xb[t * 512 + c];
                ra[t] += xv.x * wa0 + xv.y * wa1 + xv.z * wa2 + xv.w * wa3;
                ri[t] += xv.x * wx0 + xv.y * wx1 + xv.z * wx2 + xv.w * wx3;
            }
        }
    }
    __syncthreads();
    const float sp = log1pf(expf(-a.in[9][ch]));
    const float ba = a.in[6][ch], bx = a.in[8][ch];
    float h = 0.f, lasum = 0.f;
    if (APPLY) {
        for (int i = 0; i < j; ++i) { const float A = AGG[((size_t)(b * 32 + i) * 2 + 0) * 512 + ch], H = AGG[((size_t)(b * 32 + i) * 2 + 1) * 512 + ch]; h = A * h + H; }
    }
#pragma unroll
    for (int t = 0; t < 64; ++t) {
        const float xc = XC[t * 512 + ch];
        const float rg = sigmoidf_(ra[t] + ba), ig = sigmoidf_(ri[t] + bx);
        const float la = -8.0f * rg * sp;
        const float av = expf(la);
        const float u = sqrtf(-expm1f(2.0f * la)) * (ig * xc);
        h = av * h + u;
        if (APPLY) XC[t * 512 + ch] = h * bf2f(GL[(row0 + t) * 512 + ch]);
        else lasum += la;
    }
    if (!APPLY) {
        AGG[((size_t)(b * 32 + j) * 2 + 0) * 512 + ch] = expf(lasum);
        AGG[((size_t)(b * 32 + j) * 2 + 1) * 512 + ch] = h;
        return;
    }
    __syncthreads();
    bf16* Y = (bf16*)(F.ws + WS_Y);
    const f32x4 g0 = *(const GAS f32x4*)(a.in[10] + F.lane * 8), g1 = *(const GAS f32x4*)(a.in[10] + F.lane * 8 + 4);
#pragma unroll
    for (int i = 0; i < 8; ++i) {
        const int t = F.wave + 8 * i;
        const f32x4 y0 = *(const LAS f32x4*)&XC[t * 512 + F.lane * 8], y1 = *(const LAS f32x4*)&XC[t * 512 + F.lane * 8 + 4];
        float ss = (y0.x * y0.x + y0.y * y0.y) + (y0.z * y0.z + y0.w * y0.w) + (y1.x * y1.x + y1.y * y1.y) + (y1.z * y1.z + y1.w * y1.w);
        const float r = 1.0f / sqrtf(wave_sum(ss) * (1.0f / LW) + EPS);
        v4u o; o.x = pk2(y0.x * r * g0.x, y0.y * r * g0.y); o.y = pk2(y0.z * r * g0.z, y0.w * r * g0.w); o.z = pk2(y1.x * r * g1.x, y1.y * r * g1.y); o.w = pk2(y1.z * r * g1.z, y1.w * r * g1.w);
        *(GAS v4u*)(Y + (row0 + t) * DM + F.lane * 8) = o;
    }
}


namespace lru {
typedef float f32x16 __attribute__((ext_vector_type(16)));
typedef short bf16x8 __attribute__((ext_vector_type(8)));
constexpr int XCB_W = 9216, RI_OFF = 8 * XCB_W, RI_W = 8192;
static_assert(RI_OFF + 8 * RI_W <= SCR_BYTES, "lru lds");
__device__ __forceinline__ float neg_expm1_small(float x) {
    const float p = x * (1.0f + x * (0.5f + x * (0.16666667f + x * (0.041666668f + x * (0.0083333338f + x * 0.0013888889f)))));
    return -p;
}
__device__ __forceinline__ float fsig(float x) { return __builtin_amdgcn_rcpf(1.0f + __builtin_amdgcn_exp2f(-LOG2E * x)); }
__device__ __forceinline__ unsigned short hbf(float x) { return __builtin_bit_cast(unsigned short, (__bf16)x); }
template <bool APPLY>
__device__ __forceinline__ void chunk(Frame& F, const Args& a, int b, int j, const bf16x8 (&wfr)[2][2][4]) {
    const int ch = F.tid, lane = F.lane, wv = F.wave, r32 = lane & 31, hi = lane >> 5;
    const size_t row0 = (size_t)b * SEQ + (size_t)j * 64;
    const bf16* XL = (const bf16*)(F.ws + WS_XL); const bf16* GL = (const bf16*)(F.ws + WS_GL);
    float* AGG = (float*)(F.ws + WS_AGG);
    LAS bf16* xcb = (LAS bf16*)(F.lds + wv * XCB_W);
    LAS unsigned* ri = (LAS unsigned*)(F.lds + RI_OFF + wv * RI_W);
    __syncthreads();
    float xc[64];
    {
        const float cw0 = a.in[3][ch], cw1 = a.in[3][512 + ch], cw2 = a.in[3][1024 + ch], cw3 = a.in[3][1536 + ch], cb = a.in[4][ch];
        float x0 = 0.f, x1 = 0.f, x2 = 0.f;
        if (j > 0) { x0 = bf2f(XL[(row0 - 3) * 512 + ch]); x1 = bf2f(XL[(row0 - 2) * 512 + ch]); x2 = bf2f(XL[(row0 - 1) * 512 + ch]); }
#pragma unroll
        for (int t = 0; t < 64; ++t) {
            const float x3 = bf2f(XL[(row0 + t) * 512 + ch]);
            xc[t] = cb + cw0 * x0 + cw1 * x1 + cw2 * x2 + cw3 * x3;
            xcb[t * 72 + lane] = hbf(xc[t]);
            x0 = x1; x1 = x2; x2 = x3;
        }
    }
    const float sp = log1pf(expf(-a.in[9][ch]));
    const float ba0 = a.in[6][wv * 64 + r32], ba1 = a.in[6][wv * 64 + 32 + r32], bx0 = a.in[8][wv * 64 + r32], bx1 = a.in[8][wv * 64 + 32 + r32];
    float h = 0.f, lasum = 0.f;
    if (APPLY) {
        const float* ag = AGG + (size_t)b * 32 * 2 * 512 + ch;
        int i = 0;
        for (; i + 8 <= j; i += 8) {
            float A[8], H[8];
#pragma unroll
            for (int q = 0; q < 8; ++q) { A[q] = ag[(size_t)((i + q) * 2 + 0) * 512]; H[q] = ag[(size_t)((i + q) * 2 + 1) * 512]; }
#pragma unroll
            for (int q = 0; q < 8; ++q) h = A[q] * h + H[q];
        }
        for (; i < j; ++i) { const float A = ag[(size_t)(i * 2 + 0) * 512], H = ag[(size_t)(i * 2 + 1) * 512]; h = A * h + H; }
    }
#pragma unroll
    for (int th = 0; th < 2; ++th) {
        asm volatile("s_waitcnt lgkmcnt(0)" ::: "memory");
        {
            bf16x8 af[4];
#pragma unroll
            for (int ks = 0; ks < 4; ++ks) af[ks] = *(const LAS bf16x8*)(xcb + (32 * th + r32) * 72 + 16 * ks + 8 * hi);
            f32x16 acc[2][2];
#pragma unroll
            for (int g = 0; g < 2; ++g)
#pragma unroll
                for (int dt = 0; dt < 2; ++dt) {
#pragma unroll
                    for (int r = 0; r < 16; ++r) acc[g][dt][r] = 0.f;
#pragma unroll
                    for (int ks = 0; ks < 4; ++ks) acc[g][dt] = __builtin_amdgcn_mfma_f32_32x32x16_bf16(af[ks], wfr[g][dt][ks], acc[g][dt], 0, 0, 0);
                }
#pragma unroll
            for (int dt = 0; dt < 2; ++dt)
#pragma unroll
                for (int r = 0; r < 16; ++r) {
                    const int tl = (r & 3) + 8 * (r >> 2) + 4 * hi;
                    const float rv = fsig(acc[0][dt][r] + (dt ? ba1 : ba0)), iv = fsig(acc[1][dt][r] + (dt ? bx1 : bx0));
                    ri[tl * 64 + 32 * dt + r32] = (unsigned)(rv * 65535.0f + 0.5f) | ((unsigned)(iv * 65535.0f + 0.5f) << 16);
                }
        }
        asm volatile("s_waitcnt lgkmcnt(0)" ::: "memory");
#pragma unroll
        for (int tt = 0; tt < 32; ++tt) {
            const int t = 32 * th + tt;
            const unsigned w = ri[tt * 64 + lane];
            const float rg = (float)(w & 0xffffu) * (1.0f / 65535.0f), ig = (float)(w >> 16) * (1.0f / 65535.0f);
            const float la = -8.0f * rg * sp;
            const float av = __builtin_amdgcn_exp2f(LOG2E * la);
            const float u = __builtin_amdgcn_sqrtf(neg_expm1_small(2.0f * la)) * (ig * xc[t]);
            h = av * h + u;
            if (APPLY) xc[t] = h;
            else lasum += la;
        }
    }
    if (!APPLY) {
        AGG[((size_t)(b * 32 + j) * 2 + 0) * 512 + ch] = __expf(lasum);
        AGG[((size_t)(b * 32 + j) * 2 + 1) * 512 + ch] = h;
        return;
    }
    bf16* Y = (bf16*)(F.ws + WS_Y);
    v4u glv[8];
#pragma unroll
    for (int i = 0; i < 8; ++i) glv[i] = *(const GAS v4u*)(GL + (row0 + wv + 8 * i) * 512 + lane * 8);
    __syncthreads();
    LAS float* Ys = (LAS float*)F.lds;
#pragma unroll
    for (int t = 0; t < 64; ++t) Ys[t * 512 + ch] = xc[t];
    __syncthreads();
    const f32x4 g0 = *(const GAS f32x4*)(a.in[10] + lane * 8), g1 = *(const GAS f32x4*)(a.in[10] + lane * 8 + 4);
#pragma unroll
    for (int i = 0; i < 8; ++i) {
        const int t = wv + 8 * i;
        f32x4 y0 = *(const LAS f32x4*)&Ys[t * 512 + lane * 8], y1 = *(const LAS f32x4*)&Ys[t * 512 + lane * 8 + 4];
        y0.x *= bflo(glv[i].x); y0.y *= bfhi(glv[i].x); y0.z *= bflo(glv[i].y); y0.w *= bfhi(glv[i].y);
        y1.x *= bflo(glv[i].z); y1.y *= bfhi(glv[i].z); y1.z *= bflo(glv[i].w); y1.w *= bfhi(glv[i].w);
        float ss = (y0.x * y0.x + y0.y * y0.y) + (y0.z * y0.z + y0.w * y0.w) + (y1.x * y1.x + y1.y * y1.y) + (y1.z * y1.z + y1.w * y1.w);
        const float r = __builtin_amdgcn_rsqf(wave_sum(ss) * (1.0f / LW) + EPS);
        v4u o; o.x = pk2(y0.x * r * g0.x, y0.y * r * g0.y); o.y = pk2(y0.z * r * g0.z, y0.w * r * g0.w); o.z = pk2(y1.x * r * g1.x, y1.y * r * g1.y); o.w = pk2(y1.z * r * g1.z, y1.w * r * g1.w);
        *(GAS v4u*)(Y + (row0 + t) * DM + lane * 8) = o;
    }
}
template <bool APPLY>
__device__ __forceinline__ void run(Frame& F, const Args& a) {
    const int r32 = F.lane & 31, hi = F.lane >> 5;
    const bf16* Wt = (const bf16*)(F.ws + WS_WGATE) + (size_t)F.wave * 4096 + (size_t)r32 * 64 + hi * 8;
    bf16x8 wfr[2][2][4];
#pragma unroll
    for (int g = 0; g < 2; ++g)
#pragma unroll
        for (int dt = 0; dt < 2; ++dt)
#pragma unroll
            for (int ks = 0; ks < 4; ++ks) wfr[g][dt][ks] = *(const GAS bf16x8*)(Wt + g * 32768 + dt * 2048 + ks * 16);
    for (int i = F.vcu; i < BATCH * 32; i += F.G) chunk<APPLY>(F, a, i >> 5, i & 31, wfr);
}
}

__device__ __forceinline__ void nattn_unit(Frame& F, const Args& a, int b, int h, int c, float lam) {
    LAS float* Qs = (LAS float*)F.lds; LAS float* Ks = Qs + 64 * 132; LAS float* Vs = Ks + 64 * 132; LAS float* Ps = Vs + 64 * 132;
    const bf16* Qg = (const bf16*)(F.ws + WS_Q); const bf16* Kg = (const bf16*)(F.ws + WS_K); const bf16* Vg = (const bf16*)(F.ws + WS_V);
    const int tid = F.tid, qi = tid >> 3, sub = tid & 7;
    const float slope2 = exp2f(-2.0f * (float)(h + 1)) * LOG2E;
    __syncthreads();
    {
        const bf16* src = Qg + ((size_t)b * SEQ + 64 * c + qi) * 512 + h * 128 + sub * 16;
        const v4u v0 = *(const GAS v4u*)src, v1 = *(const GAS v4u*)(src + 8);
        LAS float* d = Qs + qi * 132 + sub * 16;
#pragma unroll
        for (int i = 0; i < 4; ++i) { d[2 * i] = bflo(v0[i]); d[2 * i + 1] = bfhi(v0[i]); d[8 + 2 * i] = bflo(v1[i]); d[8 + 2 * i + 1] = bfhi(v1[i]); }
    }
    float m0 = -1e30f, m1 = -1e30f, l0 = 0.f, l1 = 0.f, O0[16], O1[16];
#pragma unroll
    for (int i = 0; i < 16; ++i) { O0[i] = 0.f; O1[i] = 0.f; }
    for (int kt = 0; kt <= c; ++kt) {
        __syncthreads();
        {
            const size_t off = ((size_t)b * SEQ + 64 * kt + qi) * 512 + h * 128 + sub * 16;
            const v4u k0 = *(const GAS v4u*)(Kg + off), k1 = *(const GAS v4u*)(Kg + off + 8);
            const v4u v0 = *(const GAS v4u*)(Vg + off), v1 = *(const GAS v4u*)(Vg + off + 8);
            LAS float* dk = Ks + qi * 132 + sub * 16; LAS float* dv = Vs + qi * 132 + sub * 16;
#pragma unroll
            for (int i = 0; i < 4; ++i) {
                dk[2 * i] = bflo(k0[i]); dk[2 * i + 1] = bfhi(k0[i]); dk[8 + 2 * i] = bflo(k1[i]); dk[8 + 2 * i + 1] = bfhi(k1[i]);
                dv[2 * i] = bflo(v0[i]); dv[2 * i + 1] = bfhi(v0[i]); dv[8 + 2 * i] = bflo(v1[i]); dv[8 + 2 * i + 1] = bfhi(v1[i]);
            }
        }
        __syncthreads();
        float e0[8], e1[8];
#pragma unroll
        for (int j = 0; j < 8; ++j) {
            const int kk = sub + 8 * j;
            float s0 = 0.f, s1 = 0.f;
#pragma unroll
            for (int d = 0; d < 64; d += 4) {
                const f32x4 q0 = *(const LAS f32x4*)&Qs[qi * 132 + d], k0 = *(const LAS f32x4*)&Ks[kk * 132 + d];
                const f32x4 q1 = *(const LAS f32x4*)&Qs[qi * 132 + 64 + d], k1 = *(const LAS f32x4*)&Ks[kk * 132 + 64 + d];
                s0 += (q0.x * k0.x + q0.y * k0.y) + (q0.z * k0.z + q0.w * k0.w);
                s1 += (q1.x * k1.x + q1.y * k1.y) + (q1.z * k1.z + q1.w * k1.w);
            }
            const int dist = (64 * c + qi) - (64 * kt + kk);
            const float bias = -slope2 * (float)(dist < 0 ? -dist : dist);
            e0[j] = s0 + bias; e1[j] = s1 + bias;
        }
        {
            float tm = e0[0];
#pragma unroll
            for (int j = 1; j < 8; ++j) tm = fmaxf(tm, e0[j]);
            tm = max8lanes(tm);
            const float mn = fmaxf(m0, tm), al = exp2f(m0 - mn);
            float ps = 0.f;
#pragma unroll
            for (int j = 0; j < 8; ++j) { const float p = exp2f(e0[j] - mn); ps += p; Ps[qi * 65 + sub + 8 * j] = p; }
            ps = sum8lanes(ps);
            l0 = l0 * al + ps; m0 = mn;
#pragma unroll
            for (int i = 0; i < 16; ++i) O0[i] *= al;
        }
        {
            float tm = e1[0];
#pragma unroll
            for (int j = 1; j < 8; ++j) tm = fmaxf(tm, e1[j]);
            tm = max8lanes(tm);
            const float mn = fmaxf(m1, tm), al = exp2f(m1 - mn);
            float ps = 0.f;
#pragma unroll
            for (int j = 0; j < 8; ++j) { const float p = exp2f(e1[j] - mn); ps += p; Ps[(64 + qi) * 65 + sub + 8 * j] = p; }
            ps = sum8lanes(ps);
            l1 = l1 * al + ps; m1 = mn;
#pragma unroll
            for (int i = 0; i < 16; ++i) O1[i] *= al;
        }
        __syncthreads();
#pragma unroll 4
        for (int kk = 0; kk < 64; ++kk) {
            const float p0 = Ps[qi * 65 + kk], p1 = Ps[(64 + qi) * 65 + kk];
            const LAS f32x4* vp = (const LAS f32x4*)&Vs[kk * 132 + sub * 16];
#pragma unroll
            for (int q = 0; q < 4; ++q) { const f32x4 v = vp[q];
                O0[4 * q] += p0 * v.x; O0[4 * q + 1] += p0 * v.y; O0[4 * q + 2] += p0 * v.z; O0[4 * q + 3] += p0 * v.w;
                O1[4 * q] += p1 * v.x; O1[4 * q + 1] += p1 * v.y; O1[4 * q + 2] += p1 * v.z; O1[4 * q + 3] += p1 * v.w; }
        }
    }
    const float il0 = 1.0f / l0, il1 = lam / l1;
    float o[16], ss = 0.f;
#pragma unroll
    for (int i = 0; i < 16; ++i) { o[i] = O0[i] * il0 - O1[i] * il1; ss += o[i] * o[i]; }
    ss = sum8lanes(ss);
    const float r = (1.0f / sqrtf(ss * (1.0f / VD) + EPS)) * 0.8f;
    const float* sg = a.in[17] + sub * 16;
    float o8a[8], o8b[8];
#pragma unroll
    for (int i = 0; i < 8; ++i) { o8a[i] = o[i] * r * sg[i]; o8b[i] = o[8 + i] * r * sg[8 + i]; }
    bf16* dst = (bf16*)(F.ws + WS_Y) + ((size_t)b * SEQ + 64 * c + qi) * DM + 512 + h * 128 + sub * 16;
    *(GAS v4u*)dst = pack8(o8a); *(GAS v4u*)(dst + 8) = pack8(o8b);
}
__device__ __forceinline__ float diff_lambda(const Args& a) {
    float s1 = 0.f, s2 = 0.f;
    for (int i = 0; i < HD; ++i) { s1 += a.in[13][i] * a.in[14][i]; s2 += a.in[15][i] * a.in[16][i]; }
    return expf(s1) - expf(s2) + 0.2f;
}
__device__ __forceinline__ void p3_simple(Frame& F, const Args& a) {
    const float lam = diff_lambda(a);
    for (int i = F.vcu; i < BATCH * NH * 32; i += F.G) { const int c = 31 - (i >> 6), bh = i & 63; nattn_unit(F, a, bh >> 2, bh & 3, c, lam); }
    for (int i = F.vcu; i < BATCH * 32; i += F.G) lru_chunk<true>(F, a, i >> 5, i & 31);
}


namespace da {
typedef float f32x16 __attribute__((ext_vector_type(16)));
typedef short bf16x8 __attribute__((ext_vector_type(8)));
typedef short s16x4 __attribute__((ext_vector_type(4)));
typedef __attribute__((address_space(3))) const char* lds_cptr;
constexpr int L_K = 0, L_V = 32768, L_WS = 65536, L_STG = 65536 + 2048, L_END = L_STG + 4 * 8192;
__device__ __forceinline__ int crow(int r, int hi) { return (r & 3) + 8 * (r >> 2) + 4 * hi; }
typedef float f32x2_t __attribute__((ext_vector_type(2))); typedef __bf16 bf16x2_t __attribute__((ext_vector_type(2)));
__device__ __forceinline__ unsigned cvtpk(float lo, float hi) { f32x2_t v = {lo, hi}; bf16x2_t b = __builtin_convertvector(v, bf16x2_t); return __builtin_bit_cast(unsigned, b); }
__device__ __forceinline__ s16x4 vtr(lds_cptr p) { return __builtin_bit_cast(s16x4, __builtin_amdgcn_ds_read_tr16_b64_v4i16((__attribute__((address_space(3))) s16x4*)p)); }

__device__ __forceinline__ void unit(LAS unsigned char* lds, const bf16* Qg, const bf16* Kg, const bf16* Vg, bf16* Yg, const float* subg, int b, int h, int qb, float lam) {
    const int tid = opaque_tid(), lane = tid & 63, r32 = lane & 31, hi = lane >> 5; const int wid = __builtin_amdgcn_readfirstlane(tid >> 6);
    const int comp = wid >> 2, rb = wid & 3, co = rb >> 1;
    const int cq = 2 * qb + co, NT = 2 * qb + 2;
    const size_t rowbase = (size_t)b * SEQ; const int qrow0 = 128 * qb + 32 * rb;
    const float sl2 = exp2f(-2.0f * (float)(h + 1)) * LOG2E;
    bf16x8 qr[4];
    { const bf16* Qw = Qg + (rowbase + qrow0 + r32) * 512 + h * 128 + comp * 64 + hi * 8;
#pragma unroll
      for (int d0 = 0; d0 < 4; ++d0) qr[d0] = *(const GAS bf16x8*)(Qw + d0 * 16); }
    const bf16* ksrc = Kg + (rowbase + lane) * 512 + h * 128 + wid * 8;
    const bf16* vsrc = Vg + (rowbase + 16 * (wid & 3) + (lane >> 2)) * 512 + h * 128 + (wid >> 2) * 32 + (lane & 3) * 8;
#define DA_DMA(t, slot) do { const size_t _o = (size_t)(t) * 64 * 512; \
        __builtin_amdgcn_global_load_lds((const unsigned*)(ksrc + _o), (LAS unsigned*)(lds + L_K + (slot) * 16384 + wid * 1024), 16, 0, 0); \
        __builtin_amdgcn_global_load_lds((const unsigned*)(ksrc + _o + 64), (LAS unsigned*)(lds + L_K + (slot) * 16384 + 8192 + wid * 1024), 16, 0, 0); \
        __builtin_amdgcn_global_load_lds((const unsigned*)(vsrc + _o), (LAS unsigned*)(lds + L_V + (slot) * 16384 + wid * 1024), 16, 0, 0); \
        __builtin_amdgcn_global_load_lds((const unsigned*)(vsrc + _o + 64), (LAS unsigned*)(lds + L_V + (slot) * 16384 + (wid + 8) * 1024), 16, 0, 0); } while (0)
    f32x16 o[4];
#pragma unroll
    for (int d0 = 0; d0 < 4; ++d0)
#pragma unroll
        for (int r = 0; r < 16; ++r) o[d0][r] = 0.f;
    float l = 0.f;
    const float qrel = (float)(32 * (rb & 1) + r32);
    const lds_cptr kp0 = (lds_cptr)lds + L_K + comp * 8192 + hi * 1024 + r32 * 16;
    const lds_cptr vp0 = (lds_cptr)lds + L_V + ((lane >> 4) & 1) * 32 + (lane & 3) * 8 + (4 * hi + ((lane & 15) >> 2)) * 64;
    DA_DMA(0, 0);
    for (int t = 0; t < NT; ++t) {
        __syncthreads();
        if (t + 1 < NT) DA_DMA(t + 1, (t + 1) & 1);
        if (t <= cq) {
            const int slot = t & 1;
            f32x16 p0, p1;
            if (t < cq) {
                const float base = -sl2 * ((float)(64 * (cq - t)) + qrel - (float)(4 * hi));
#pragma unroll
                for (int r = 0; r < 16; ++r) { p0[r] = base + sl2 * (float)((r & 3) + 8 * (r >> 2)); p1[r] = p0[r] + 32.0f * sl2; }
            } else {
#pragma unroll
                for (int r = 0; r < 16; ++r) { const float d = qrel - (float)(4 * hi) - (float)((r & 3) + 8 * (r >> 2)); p0[r] = -sl2 * fabsf(d); p1[r] = -sl2 * fabsf(d - 32.0f); }
            }
            const lds_cptr kp = kp0 + slot * 16384;
#pragma unroll
            for (int d0 = 0; d0 < 4; ++d0) {
                const bf16x8 k0 = *(const LAS bf16x8*)(kp + d0 * 2048), k1 = *(const LAS bf16x8*)(kp + d0 * 2048 + 512);
                p0 = __builtin_amdgcn_mfma_f32_32x32x16_bf16(k0, qr[d0], p0, 0, 0, 0);
                p1 = __builtin_amdgcn_mfma_f32_32x32x16_bf16(k1, qr[d0], p1, 0, 0, 0);
            }
            float sacc = 0.f;
#pragma unroll
            for (int r = 0; r < 16; ++r) { p0[r] = __builtin_amdgcn_exp2f(p0[r]); p1[r] = __builtin_amdgcn_exp2f(p1[r]); sacc += p0[r] + p1[r]; }
            l += sacc;
            bf16x8 pa[4];
            { unsigned w[16];
#pragma unroll
              for (int i = 0; i < 8; ++i) { w[i] = cvtpk(p0[2 * i], p0[2 * i + 1]); w[8 + i] = cvtpk(p1[2 * i], p1[2 * i + 1]); }
#pragma unroll
              for (int k = 0; k < 4; ++k) { v4u x = {w[4 * k], w[4 * k + 1], w[4 * k + 2], w[4 * k + 3]}; pa[k] = __builtin_bit_cast(bf16x8, x); } }
            const lds_cptr vp = vp0 + slot * 16384;
#pragma unroll
            for (int d0 = 0; d0 < 4; ++d0) {
#pragma unroll
                for (int ks = 0; ks < 4; ++ks) {
                    const s16x4 lo = vtr(vp + d0 * 4096 + ks * 1024), hh = vtr(vp + d0 * 4096 + ks * 1024 + 512);
                    const bf16x8 vf = {lo[0], lo[1], lo[2], lo[3], hh[0], hh[1], hh[2], hh[3]};
                    o[d0] = __builtin_amdgcn_mfma_f32_32x32x16_bf16(pa[ks], vf, o[d0], 0, 0, 0);
                }
            }
        }
    }
#undef DA_DMA
    { auto rr = __builtin_amdgcn_permlane32_swap(__float_as_uint(l), __float_as_uint(l), false, false); l = __uint_as_float(rr[0]) + __uint_as_float(rr[1]); }
    __syncthreads();
    LAS float* wsf = (LAS float*)(lds + L_WS) + wid * 64;
    if (hi == 0) wsf[r32] = l;
    asm volatile("s_waitcnt lgkmcnt(0)" ::: "memory");
    float rl[16];
#pragma unroll
    for (int r = 0; r < 16; ++r) rl[r] = (comp ? lam : 1.0f) / wsf[crow(r, hi)];
    LAS float* X = (LAS float*)lds + rb * 4096 + lane;
    if (comp == 1) {
#pragma unroll
        for (int d0 = 0; d0 < 4; ++d0)
#pragma unroll
            for (int r = 0; r < 16; ++r) X[(d0 * 16 + r) * 64] = o[d0][r] * rl[r];
    }
    __syncthreads();
    if (comp == 0) {
        float rn[16];
#pragma unroll
        for (int r = 0; r < 16; ++r) {
            float ss = 0.f;
#pragma unroll
            for (int d0 = 0; d0 < 4; ++d0) { o[d0][r] = o[d0][r] * rl[r] - X[(d0 * 16 + r) * 64]; ss += o[d0][r] * o[d0][r]; }
            ss += __shfl_xor(ss, 1); ss += __shfl_xor(ss, 2); ss += __shfl_xor(ss, 4); ss += __shfl_xor(ss, 8); ss += __shfl_xor(ss, 16);
            rn[r] = (1.0f / sqrtf(ss * (1.0f / VD) + EPS)) * 0.8f;
        }
        LAS bf16* stg = (LAS bf16*)(lds + L_STG) + wid * 4096;
#pragma unroll
        for (int d0 = 0; d0 < 4; ++d0) { const float gg = subg[32 * d0 + r32];
#pragma unroll
            for (int r = 0; r < 16; ++r) stg[crow(r, hi) * 128 + 32 * d0 + r32] = (bf16)f2bf(o[d0][r] * rn[r] * gg); }
        asm volatile("s_waitcnt lgkmcnt(0)" ::: "memory");
        bf16* Yw = Yg + (rowbase + qrow0) * DM + 512 + h * 128;
#pragma unroll
        for (int i = 0; i < 8; ++i) { const int row = i * 4 + (lane >> 4), ch = lane & 15; const v4u v = *(const LAS v4u*)(stg + row * 128 + ch * 8); *(GAS v4u*)(Yw + (size_t)row * DM + ch * 8) = v; }
    }
    __syncthreads();
}
}
__device__ __forceinline__ void p3_fast(Frame& F, const Args& a) {
    const float lam = diff_lambda(a);
    const bf16* Qg = (const bf16*)(F.ws + WS_Q); const bf16* Kg = (const bf16*)(F.ws + WS_K); const bf16* Vg = (const bf16*)(F.ws + WS_V); bf16* Yg = (bf16*)(F.ws + WS_Y);
    for (int P = F.vcu; P < BATCH * NH * 8; P += F.G) {
        const int bh = P >> 3, s = P & 7;
        da::unit(F.lds, Qg, Kg, Vg, Yg, a.in[17], bh >> 2, bh & 3, 15 - s, lam);
        da::unit(F.lds, Qg, Kg, Vg, Yg, a.in[17], bh >> 2, bh & 3, s, lam);
    }
    lru::run<true>(F, a);
}

__device__ __forceinline__ void p4_simple(Frame& F, const Args& a) {
    LAS float* As = (LAS float*)F.lds; LAS float* Bs = As + 64 * 65;
    const bf16* Y = (const bf16*)(F.ws + WS_Y); const bf16* Wout_t = (const bf16*)(F.ws + WS_WOUT);
    const int tid = F.tid, r = tid >> 3, cg = tid & 7;
    for (int tt = F.vcu; tt < (T / 64) * 16; tt += F.G) {
        const int rt = tt >> 4, ct = tt & 15;
        float acc[8] = {0.f, 0.f, 0.f, 0.f, 0.f, 0.f, 0.f, 0.f};
        ngemm_acc(As, Bs, DM, [&](int rr) { return Y + (size_t)(rt * 64 + rr) * DM; }, [&](int cc) { return Wout_t + (size_t)(ct * 64 + cc) * DM; }, acc);
        const size_t off = ((size_t)rt * 64 + r) * DM + ct * 64 + cg * 8;
        const f32x4 x0 = *(const GAS f32x4*)(a.in[0] + off), x1 = *(const GAS f32x4*)(a.in[0] + off + 4);
        *(GAS f32x4*)(F.out + off) = (f32x4){x0.x + acc[0], x0.y + acc[1], x0.z + acc[2], x0.w + acc[3]};
        *(GAS f32x4*)(F.out + off + 4) = (f32x4){x1.x + acc[4], x1.y + acc[5], x1.z + acc[6], x1.w + acc[7]};
    }
}

__device__ __forceinline__ void p5_route(Frame& F, const Args& a) {
    LAS float* Wr = (LAS float*)F.lds;
    __syncthreads();
    for (int i = F.tid; i < 20 * 1024; i += NTHR) {
        const int c = i >> 10, k = i & 1023;
        Wr[i] = (c < 4) ? a.in[20][k * 4 + c] : a.in[22][((size_t)((c - 4) >> 2) * 1024 + k) * 4 + ((c - 4) & 3)];
    }
    __syncthreads();
    const int gw = F.vcu * NWAVES + F.wave, NGW = F.G * NWAVES, lane = F.lane;
    bf16* HN2 = (bf16*)(F.ws + WS_XN); float* gates = (float*)(F.ws + WS_GATES); int* list = (int*)(F.ws + WS_LIST);
    const GAS f32x4* gr = (const GAS f32x4*)a.in[19] + lane;
    for (int m = gw; m < T; m += NGW) {
        const GAS f32x4* xr = (const GAS f32x4*)(F.out + (size_t)m * DM) + lane;
        f32x4 v[4]; float s = 0.f;
#pragma unroll
        for (int j = 0; j < 4; ++j) { v[j] = xr[64 * j]; s += (v[j].x * v[j].x + v[j].y * v[j].y) + (v[j].z * v[j].z + v[j].w * v[j].w); }
        const float r = 1.0f / sqrtf(wave_sum(s) * (1.0f / DM) + EPS);
        GAS v2u* o8 = (GAS v2u*)(HN2 + (size_t)m * DM) + lane;
#pragma unroll
        for (int j = 0; j < 4; ++j) { const f32x4 gg = gr[64 * j]; v[j].x *= r * gg.x; v[j].y *= r * gg.y; v[j].z *= r * gg.z; v[j].w *= r * gg.w;
            v2u w; w.x = pk2(v[j].x, v[j].y); w.y = pk2(v[j].z, v[j].w); o8[64 * j] = w; }
        float lg[20];
#pragma unroll
        for (int c = 0; c < 20; ++c) {
            float acc = 0.f;
#pragma unroll
            for (int j = 0; j < 4; ++j) { const f32x4 w = *(const LAS f32x4*)&Wr[c * 1024 + 256 * j + 4 * lane]; acc += (v[j].x * w.x + v[j].y * w.y) + (v[j].z * w.z + v[j].w * w.w); }
            lg[c] = wave_sum(acc);
            asm volatile("" ::: "memory");
        }
        float gl0 = lg[0] + a.in[21][0], gl1 = lg[1] + a.in[21][1], gl2 = lg[2] + a.in[21][2], gl3 = lg[3] + a.in[21][3];
        int gi = 0; float gm = gl0;
        if (gl1 > gm) { gm = gl1; gi = 1; } if (gl2 > gm) { gm = gl2; gi = 2; } if (gl3 > gm) { gm = gl3; gi = 3; }
        const float pg = 1.0f / (expf(gl0 - gm) + expf(gl1 - gm) + expf(gl2 - gm) + expf(gl3 - gm));
        float el[4];
#pragma unroll
        for (int e = 0; e < 4; ++e) { const float sel = gi == 0 ? lg[4 + e] : gi == 1 ? lg[8 + e] : gi == 2 ? lg[12 + e] : lg[16 + e]; el[e] = sel + a.in[23][gi * 4 + e]; }
        int e1 = 0; float v1 = el[0];
#pragma unroll
        for (int e = 1; e < 4; ++e) if (el[e] > v1) { v1 = el[e]; e1 = e; }
        int e2 = -1; float v2 = -3.0e38f;
#pragma unroll
        for (int e = 0; e < 4; ++e) if (e != e1 && el[e] > v2) { v2 = el[e]; e2 = e; }
        const float w1 = 1.0f / (1.0f + expf(v2 - v1)), w2 = 1.0f - w1;
        const int lo = e1 < e2 ? e1 : e2, hi = e1 < e2 ? e2 : e1;
        const float glo = pg * (e1 < e2 ? w1 : w2), ghi = pg * (e1 < e2 ? w2 : w1);
        const int pi = lo == 0 ? hi - 1 : (lo == 1 ? hi + 1 : 5);
        const int bk = gi * 6 + pi;
        if (lane == 0) {
            const unsigned slot = __hip_atomic_fetch_add((unsigned*)(F.ctl + CW_CNT + bk), 1u, RLX_AGENT);
            list[(size_t)bk * T + slot] = m; gates[2 * (size_t)m] = glo; gates[2 * (size_t)m + 1] = ghi;
            float* gp = (float*)(F.ws + WS_GPOS) + ((size_t)bk * T + slot) * 2; gp[0] = glo; gp[1] = ghi;
        }
    }
}


__device__ __forceinline__ float sum16(float v) { v += __shfl_xor(v, 1); v += __shfl_xor(v, 2); v += __shfl_xor(v, 4); v += __shfl_xor(v, 8); return v; }
__device__ __forceinline__ void p5_route2(Frame& F, const Args& a) {
    LAS float* Wr = (LAS float*)F.lds;
    LAS float* res = (LAS float*)(F.lds + 86016) + F.wave * 64;
    __syncthreads();
    {
        f32x4 wv[10];
#pragma unroll
        for (int q = 0; q < 10; ++q) { const int i = F.tid + q * NTHR; wv[q] = (i < 1024) ? *(const GAS f32x4*)(a.in[20] + (size_t)i * 4) : *(const GAS f32x4*)(a.in[22] + (size_t)(i - 1024) * 4); }
#pragma unroll
        for (int q = 0; q < 10; ++q) { const int i = F.tid + q * NTHR; const int k = i & 1023, c0 = (i < 1024) ? 0 : 4 + 4 * ((i - 1024) >> 10);
            Wr[(c0 + 0) * 1024 + k] = wv[q].x; Wr[(c0 + 1) * 1024 + k] = wv[q].y; Wr[(c0 + 2) * 1024 + k] = wv[q].z; Wr[(c0 + 3) * 1024 + k] = wv[q].w; }
        if (F.tid < 256) *(LAS f32x4*)&Wr[20 * 1024 + 4 * F.tid] = *((const GAS f32x4*)a.in[19] + F.tid);
    }
    __syncthreads();
    const int gw = F.vcu * NWAVES + F.wave, NGW = F.G * NWAVES, lane = F.lane, grp = lane >> 4, ll = lane & 15;
    bf16* HN2 = (bf16*)(F.ws + WS_XN); int* list = (int*)(F.ws + WS_LIST); float* gpos = (float*)(F.ws + WS_GPOS);
    const float brg0 = a.in[21][0], brg1 = a.in[21][1], brg2 = a.in[21][2], brg3 = a.in[21][3];
    for (int m0 = gw * 16; m0 < T; m0 += NGW * 16) {
        f32x4 vb[2][16];
        { const GAS f32x4* xr = (const GAS f32x4*)(F.out + (size_t)(m0 + grp) * DM) + ll;
#pragma unroll
          for (int j = 0; j < 16; ++j) vb[0][j] = xr[16 * j]; }
#pragma unroll
        for (int it = 0; it < 4; ++it) {
            const int m = m0 + it * 4 + grp;
            f32x4 (&v)[16] = vb[it & 1];
            if (it < 3) { const GAS f32x4* xr = (const GAS f32x4*)(F.out + (size_t)(m + 4) * DM) + ll;
#pragma unroll
                for (int j = 0; j < 16; ++j) vb[(it + 1) & 1][j] = xr[16 * j]; }
            float s = 0.f;
#pragma unroll
            for (int j = 0; j < 16; ++j) s += (v[j].x * v[j].x + v[j].y * v[j].y) + (v[j].z * v[j].z + v[j].w * v[j].w);
            const float r = __builtin_amdgcn_rsqf(sum16(s) * (1.0f / DM) + EPS);
            GAS v2u* o8 = (GAS v2u*)(HN2 + (size_t)m * DM) + ll;
#pragma unroll
            for (int j = 0; j < 16; ++j) { const f32x4 gg = *(const LAS f32x4*)&Wr[20 * 1024 + 64 * j + 4 * ll]; v[j].x *= r * gg.x; v[j].y *= r * gg.y; v[j].z *= r * gg.z; v[j].w *= r * gg.w;
                v2u w; w.x = pg8::cvt_pk_bf16(v[j].x, v[j].y); w.y = pg8::cvt_pk_bf16(v[j].z, v[j].w); o8[16 * j] = w; }
            float lg[4];
#pragma unroll
            for (int c = 0; c < 4; ++c) {
                float acc = 0.f;
#pragma unroll
                for (int j = 0; j < 16; ++j) { const f32x4 w = *(const LAS f32x4*)&Wr[c * 1024 + 64 * j + 4 * ll]; acc += (v[j].x * w.x + v[j].y * w.y) + (v[j].z * w.z + v[j].w * w.w); }
                lg[c] = acc;
                asm volatile("" ::: "memory");
            }
#pragma unroll
            for (int o = 1; o < 16; o <<= 1) {
#pragma unroll
                for (int c = 0; c < 4; ++c) lg[c] += __shfl_xor(lg[c], o);
            }
            float gl0 = lg[0] + brg0, gl1 = lg[1] + brg1, gl2 = lg[2] + brg2, gl3 = lg[3] + brg3;
            int gi = 0; float gm = gl0;
            if (gl1 > gm) { gm = gl1; gi = 1; } if (gl2 > gm) { gm = gl2; gi = 2; } if (gl3 > gm) { gm = gl3; gi = 3; }
            const float pg = 1.0f / (__expf(gl0 - gm) + __expf(gl1 - gm) + __expf(gl2 - gm) + __expf(gl3 - gm));
            float el[4];
            const LAS float* We = Wr + (4 + 4 * gi) * 1024 + 4 * ll;
#pragma unroll
            for (int e = 0; e < 4; ++e) {
                float acc = 0.f;
#pragma unroll
                for (int j = 0; j < 16; ++j) { const f32x4 w = *(const LAS f32x4*)&We[e * 1024 + 64 * j]; acc += (v[j].x * w.x + v[j].y * w.y) + (v[j].z * w.z + v[j].w * w.w); }
                el[e] = acc;
                asm volatile("" ::: "memory");
            }
#pragma unroll
            for (int o = 1; o < 16; o <<= 1) {
#pragma unroll
                for (int e = 0; e < 4; ++e) el[e] += __shfl_xor(el[e], o);
            }
#pragma unroll
            for (int e = 0; e < 4; ++e) el[e] += a.in[23][gi * 4 + e];
            int e1 = 0; float v1 = el[0];
#pragma unroll
            for (int e = 1; e < 4; ++e) if (el[e] > v1) { v1 = el[e]; e1 = e; }
            int e2 = -1; float v2 = -3.0e38f;
#pragma unroll
            for (int e = 0; e < 4; ++e) if (e != e1 && el[e] > v2) { v2 = el[e]; e2 = e; }
            const float w1 = 1.0f / (1.0f + __expf(v2 - v1)), w2 = 1.0f - w1;
            const int lo = e1 < e2 ? e1 : e2, hi = e1 < e2 ? e2 : e1;
            const float glo = pg * (e1 < e2 ? w1 : w2), ghi = pg * (e1 < e2 ? w2 : w1);
            const int pi = lo == 0 ? hi - 1 : (lo == 1 ? hi + 1 : 5);
            const int bk = gi * 6 + pi;
            if (ll == 0) { LAS float* rr = res + (it * 4 + grp) * 4; rr[0] = __int_as_float(bk); rr[1] = glo; rr[2] = ghi; }
        }
        LAS int* lcnt = (LAS int*)(F.lds + 86016 + 2048);
        __syncthreads();
        if (F.tid < 48) lcnt[F.tid] = 0;
        __syncthreads();
        int mybk = 0, myrank = 0;
        if (F.tid < 128) { mybk = __float_as_int(((LAS float*)(F.lds + 86016))[F.tid * 4]); myrank = __hip_atomic_fetch_add(&lcnt[mybk], 1, __ATOMIC_RELAXED, __HIP_MEMORY_SCOPE_WORKGROUP); }
        __syncthreads();
        if (F.tid < 24) { const int n = lcnt[F.tid]; lcnt[24 + F.tid] = n ? (int)__hip_atomic_fetch_add((unsigned*)(F.ctl + CW_CNT + 64 * F.tid), (unsigned)n, RLX_AGENT) : 0; }
        __syncthreads();
        if (F.tid < 128) {
            const LAS float* rr = (const LAS float*)(F.lds + 86016) + F.tid * 4;
            const unsigned slot = (unsigned)(lcnt[24 + mybk] + myrank);
            const int row = (m0 - F.wave * 16) + F.tid;
            list[(size_t)mybk * T + slot] = row;
            *(GAS v2u*)(gpos + ((size_t)mybk * T + slot) * 2) = (v2u){__float_as_uint(rr[1]), __float_as_uint(rr[2])};
        }
        __syncthreads();
    }
}

__device__ __forceinline__ void bucket_tables(Frame& F, LAS int* tb) {
    __syncthreads();
    if (F.tid == 0) {
        int off = 0, pre = 0;
        for (int k = 0; k < NBK; ++k) {
            const int c = (int)__hip_atomic_load((unsigned*)(F.ctl + CW_CNT + 64 * k), RLX_AGENT);
            tb[k] = c; tb[24 + k] = off; tb[49 + k] = pre; off += (c + 255) & ~255; pre += (c + 63) >> 6;
        }
        tb[24 + 24] = off; tb[49 + 24] = pre;
    }
    __syncthreads();
}
__device__ __forceinline__ void bk_experts(int bk, int& elo, int& ehi) {
    const int g = bk / 6, pi = bk % 6;
    const int lo = pi < 3 ? 0 : (pi < 5 ? 1 : 2), hi = pi < 3 ? pi + 1 : (pi < 5 ? pi - 1 : 3);
    elo = g * 4 + lo; ehi = g * 4 + hi;
}

__device__ __forceinline__ void p6_simple(Frame& F, const Args& a) {
    LAS float* As = (LAS float*)F.lds; LAS float* Bs = As + 64 * 65; LAS int* tb = (LAS int*)(Bs + 64 * 72);
    bucket_tables(F, tb);
    const bf16* HN2 = (const bf16*)(F.ws + WS_XN); const bf16* Wg_t = (const bf16*)(F.ws + WS_WG); const bf16* Wu_t = (const bf16*)(F.ws + WS_WU);
    const float* gates = (const float*)(F.ws + WS_GATES); const int* list = (const int*)(F.ws + WS_LIST);
    bf16* HID = (bf16*)(F.ws + WS_HID);
    const int tid = F.tid, r = tid >> 3, cg = tid & 7;
    const int ntile = tb[49 + 24];
    for (int u = F.vcu; u < ntile * 16; u += F.G) {
        const int tile = u >> 4, x = (u >> 3) & 1, jt = u & 7;
        int bk = 0;
        for (int k = 1; k < NBK; ++k) if (tile >= tb[49 + k]) bk = k;
        const int rt = tile - tb[49 + bk], cnt = tb[bk], off = tb[24 + bk];
        int elo, ehi; bk_experts(bk, elo, ehi); const int e = x ? ehi : elo;
        const int idx = rt * 64 + r; const bool valid = idx < cnt;
        const int tok = list[(size_t)bk * T + (valid ? idx : 0)];
        const float gate = valid ? gates[2 * (size_t)tok + x] : 0.f;
        float ag[8] = {0.f, 0.f, 0.f, 0.f, 0.f, 0.f, 0.f, 0.f}, au[8] = {0.f, 0.f, 0.f, 0.f, 0.f, 0.f, 0.f, 0.f};
        ngemm_acc(As, Bs, DM, [&](int) { return HN2 + (size_t)tok * DM; }, [&](int cc) { return Wg_t + ((size_t)e * DE + jt * 64 + cc) * DM; }, ag);
        ngemm_acc(As, Bs, DM, [&](int) { return HN2 + (size_t)tok * DM; }, [&](int cc) { return Wu_t + ((size_t)e * DE + jt * 64 + cc) * DM; }, au);
        float hv[8];
#pragma unroll
        for (int j = 0; j < 8; ++j) hv[j] = ag[j] * sigmoidf_(ag[j]) * au[j] * gate;
        *(GAS v4u*)(HID + (size_t)(off + idx) * DM + x * 512 + jt * 64 + cg * 8) = pack8(hv);
    }
}
__device__ __forceinline__ void p7_simple(Frame& F, const Args& a) {
    LAS float* As = (LAS float*)F.lds; LAS float* Bs = As + 64 * 65; LAS int* tb = (LAS int*)(Bs + 64 * 72);
    bucket_tables(F, tb);
    const bf16* HID = (const bf16*)(F.ws + WS_HID); const bf16* Wd_t = (const bf16*)(F.ws + WS_WD);
    const int* list = (const int*)(F.ws + WS_LIST);
    const int tid = F.tid, r = tid >> 3, cg = tid & 7;
    const int ntile = tb[49 + 24];
    for (int u = F.vcu; u < ntile * 16; u += F.G) {
        const int tile = u >> 4, ct = u & 15;
        int bk = 0;
        for (int k = 1; k < NBK; ++k) if (tile >= tb[49 + k]) bk = k;
        const int rt = tile - tb[49 + bk], cnt = tb[bk], off = tb[24 + bk];
        int elo, ehi; bk_experts(bk, elo, ehi);
        const int idx = rt * 64 + r; const bool valid = idx < cnt;
        float acc[8] = {0.f, 0.f, 0.f, 0.f, 0.f, 0.f, 0.f, 0.f};
        ngemm_acc(As, Bs, DE, [&](int rr) { return HID + (size_t)(off + rt * 64 + rr) * DM; }, [&](int cc) { return Wd_t + ((size_t)elo * DM + ct * 64 + cc) * DE; }, acc);
        ngemm_acc(As, Bs, DE, [&](int rr) { return HID + (size_t)(off + rt * 64 + rr) * DM + 512; }, [&](int cc) { return Wd_t + ((size_t)ehi * DM + ct * 64 + cc) * DE; }, acc);
        if (valid) {
            const int tok = list[(size_t)bk * T + idx];
            const size_t o = (size_t)tok * DM + ct * 64 + cg * 8;
            const f32x4 h0 = *(const GAS f32x4*)(F.out + o), h1 = *(const GAS f32x4*)(F.out + o + 4);
            *(GAS f32x4*)(F.out + o) = (f32x4){h0.x + acc[0], h0.y + acc[1], h0.z + acc[2], h0.w + acc[3]};
            *(GAS f32x4*)(F.out + o + 4) = (f32x4){h1.x + acc[4], h1.y + acc[5], h1.z + acc[6], h1.w + acc[7]};
        }
    }
}


struct EpiOutRes {
    const float* x; float* out;
    __device__ __forceinline__ void operator()(const f32x4 (&acc)[2][2][4][2], const pg8::GUnit& u, int wr, int wc, int fr, int fq) const {
        const size_t row0 = (size_t)u.pm * 256 + wr * 64 + fr; const int col0 = u.pn * 256 + wc * 32 + 4 * fq;
#pragma unroll
        for (int ai = 0; ai < 2; ++ai)
#pragma unroll
            for (int m = 0; m < 4; ++m) { const size_t off = (row0 + ai * 128 + m * 16) * DM + col0;
#pragma unroll
                for (int bj = 0; bj < 2; ++bj)
#pragma unroll
                    for (int n = 0; n < 2; ++n) { const f32x4 xv = *(const GAS f32x4*)(x + off + bj * 128 + n * 16); *(GAS f32x4*)(out + off + bj * 128 + n * 16) = xv + acc[ai][bj][m][n]; }
                if (m & 1) asm volatile("" ::: "memory"); }
    }
};
__device__ __forceinline__ void p4_fast(Frame& F, const Args& a) {
    pg8::GemmCfg g; g.nt = DM / 64; g.kseg = g.nt; g.lda = DM * 2; g.ldb = DM * 2; g.hstepA = (size_t)128 * DM * 2; g.hstepB = (size_t)128 * DM * 2; g.bmap = pg8::MAP_NAT; g.glist = nullptr;
    pg8::TileOrder S; S.nM = T / 256; S.nN = DM / 256; S.G = F.G; S.c = F.vcu; S.A = (const char*)(F.ws + WS_Y); S.B = (const char*)(F.ws + WS_WOUT); S.tstepA = (size_t)256 * DM * 2; S.tstepB = (size_t)256 * DM * 2;
    EpiOutRes E; E.x = a.in[0]; E.out = F.out;
    pg8::gemm_phase<EpiOutRes, pg8::TileOrder, false, false>(F.lds, g, S, E);
}

constexpr int TB_OFF = 131072, TB_PRE = 24, TB_R6 = 64, TB_R7 = 384;
__device__ __forceinline__ void moe_tables(Frame& F) {
    LAS int* tb = (LAS int*)(F.lds + TB_OFF);
    __syncthreads();
    if (F.tid == 0) {
        int pre = 0;
        for (int k = 0; k < NBK; ++k) { const int c = (int)__hip_atomic_load((unsigned*)(F.ctl + CW_CNT + 64 * k), RLX_AGENT); tb[k] = c; tb[TB_PRE + k] = pre; pre += (c + 255) >> 8; }
        tb[TB_PRE + 24] = pre;
    }
    __syncthreads();
    const int np = tb[TB_PRE + 24];
    for (int q = F.tid; q < 2 * np; q += NTHR) {
        int bk = 0;
        for (int k = 1; k < NBK; ++k) if (q >= 2 * tb[TB_PRE + k]) bk = k;
        const int ntk = tb[TB_PRE + bk + 1] - tb[TB_PRE + bk]; const int r = q - 2 * tb[TB_PRE + bk]; const int x = r >= ntk ? 1 : 0; const int rt = r - x * ntk;
        tb[TB_R6 + q] = bk | (x << 8) | (rt << 16);
    }
    for (int q = F.tid; q < np; q += NTHR) {
        int bk = 0;
        for (int k = 1; k < NBK; ++k) if (q >= tb[TB_PRE + k]) bk = k;
        tb[TB_R7 + q] = bk | ((q - tb[TB_PRE + bk]) << 16);
    }
    __syncthreads();
}
struct MoeUpOrder {
    const LAS int* tb; int G, c; const char* hn2; const char* wg;
    __device__ __forceinline__ bool next(int i, pg8::GUnit& u) const {
        const int L = i * G + c; const int nq = 2 * tb[TB_PRE + 24]; if (L >= 4 * nq) return false;
        const int q = L >> 2, pn = L & 3; const int w = tb[TB_R6 + q]; const int bk = w & 255, x = (w >> 8) & 1, rt = w >> 16;
        int elo, ehi; bk_experts(bk, elo, ehi); const int e = x ? ehi : elo;
        u.A = hn2; u.B = wg + ((size_t)e * DE + pn * 128) * (DM * 2); u.B2 = nullptr;
        u.pm = bk * T; u.e0 = rt * 256; u.e1 = tb[bk] - rt * 256; u.pn = pn | (x << 8) | ((tb[TB_PRE + bk] + rt) << 16);
        return true;
    }
};
struct EpiGateUp {
    bf16* hid; const float* gpos;
    __device__ __forceinline__ void operator()(const f32x4 (&acc)[2][2][4][2], const pg8::GUnit& u, int wr, int wc, int fr, int fq) const {
        const int pn = u.pn & 255, x = (u.pn >> 8) & 1, trow = u.pn >> 16;
        const int col0 = x * 512 + pn * 128 + 32 * wc + 8 * fq;
#pragma unroll
        for (int ai = 0; ai < 2; ++ai)
#pragma unroll
            for (int m = 0; m < 4; ++m) {
                const int it = ai * 128 + wr * 64 + m * 16 + fr; const bool valid = it < u.e1;
                const float gate = valid ? gpos[((size_t)u.pm + u.e0 + it) * 2 + x] : 0.f;
                float hv[8];
#pragma unroll
                for (int n = 0; n < 2; ++n) { const f32x4 gv = acc[ai][0][m][n], uv = acc[ai][1][m][n];
                    hv[4 * n + 0] = gv.x * sigmoidf_(gv.x) * uv.x * gate; hv[4 * n + 1] = gv.y * sigmoidf_(gv.y) * uv.y * gate;
                    hv[4 * n + 2] = gv.z * sigmoidf_(gv.z) * uv.z * gate; hv[4 * n + 3] = gv.w * sigmoidf_(gv.w) * uv.w * gate; }
                v4u w; w.x = pg8::cvt_pk_bf16(hv[0], hv[1]); w.y = pg8::cvt_pk_bf16(hv[2], hv[3]); w.z = pg8::cvt_pk_bf16(hv[4], hv[5]); w.w = pg8::cvt_pk_bf16(hv[6], hv[7]);
                *(GAS v4u*)(hid + ((size_t)trow * 256 + it) * DM + col0) = w;
            }
    }
};
__device__ __forceinline__ void p6_fast(Frame& F, const Args& a) {
    moe_tables(F);
    pg8::GemmCfg g; g.nt = DM / 64; g.kseg = g.nt; g.lda = DM * 2; g.ldb = DM * 2; g.hstepA = 0; g.hstepB = (size_t)(WS_WU - WS_WG); g.bmap = pg8::MAP_P32; g.glist = (const int*)(F.ws + WS_LIST);
    MoeUpOrder S; S.tb = (const LAS int*)(F.lds + TB_OFF); S.G = F.G; S.c = F.vcu; S.hn2 = (const char*)(F.ws + WS_XN); S.wg = (const char*)(F.ws + WS_WG);
    EpiGateUp E; E.hid = (bf16*)(F.ws + WS_HID); E.gpos = (const float*)(F.ws + WS_GPOS);
    pg8::gemm_phase<EpiGateUp, MoeUpOrder, true, false>(F.lds, g, S, E);
}
struct MoeDownOrder {
    const LAS int* tb; int G, c; const char* hid; const char* wd;
    __device__ __forceinline__ bool next(int i, pg8::GUnit& u) const {
        const int L = i * G + c; const int nM = tb[TB_PRE + 24]; if (L >= 4 * nM) return false;
        const int nig = 32, gid = L / nig, fm = gid * 8, gsz = (nM - fm) < 8 ? (nM - fm) : 8;
        const int q = fm + ((L % nig) % gsz), pn = (L % nig) / gsz;
        const int w = tb[TB_R7 + q]; const int bk = w & 255, rt = w >> 16;
        int elo, ehi; bk_experts(bk, elo, ehi);
        u.A = hid + (size_t)q * 256 * (DM * 2); u.B = wd + ((size_t)elo * DM + pn * 256) * (DE * 2); u.B2 = wd + ((size_t)ehi * DM + pn * 256) * (DE * 2);
        u.pm = bk * T; u.e0 = rt * 256; u.e1 = tb[bk] - rt * 256; u.pn = pn;
        return true;
    }
};
struct EpiDown {
    float* out; const int* list;
    __device__ __forceinline__ void operator()(const f32x4 (&acc)[2][2][4][2], const pg8::GUnit& u, int wr, int wc, int fr, int fq) const {
        const int col0 = u.pn * 256 + wc * 32 + 4 * fq;
#pragma unroll
        for (int ai = 0; ai < 2; ++ai)
#pragma unroll
            for (int m = 0; m < 4; ++m) {
                const int it = ai * 128 + wr * 64 + m * 16 + fr;
                if (it < u.e1) {
                    const int tok = list[u.pm + u.e0 + it]; float* rowp = out + (size_t)tok * DM + col0;
#pragma unroll
                    for (int bj = 0; bj < 2; ++bj)
#pragma unroll
                        for (int n = 0; n < 2; ++n) { const f32x4 hv = *(const GAS f32x4*)(rowp + bj * 128 + n * 16); *(GAS f32x4*)(rowp + bj * 128 + n * 16) = hv + acc[ai][bj][m][n]; }
                }
                if (m & 1) asm volatile("" ::: "memory");
            }
    }
};
__device__ __forceinline__ void p7_fast(Frame& F, const Args& a) {
    moe_tables(F);
    pg8::GemmCfg g; g.nt = DM / 64; g.kseg = 8; g.lda = DM * 2; g.ldb = DE * 2; g.hstepA = (size_t)128 * DM * 2; g.hstepB = (size_t)128 * DE * 2; g.bmap = pg8::MAP_NAT; g.glist = nullptr;
    MoeDownOrder S; S.tb = (const LAS int*)(F.lds + TB_OFF); S.G = F.G; S.c = F.vcu; S.hid = (const char*)(F.ws + WS_HID); S.wd = (const char*)(F.ws + WS_WD);
    EpiDown E; E.out = F.out; E.list = (const int*)(F.ws + WS_LIST);
    pg8::gemm_phase<EpiDown, MoeDownOrder, false, true>(F.lds, g, S, E);
}

__global__ void __launch_bounds__(NTHR, 2) fwd_kernel(Args args) {
    extern __shared__ __attribute__((aligned(16))) unsigned char lds[];
    Frame F;
    F.lds = (LAS unsigned char*)lds;
    F.MISC = (volatile LAS unsigned*)(F.lds + MISC_OFF);
    F.retid();
    F.G = gridDim.x; { const int bx = blockIdx.x; F.vcu = (F.G % 8 == 0) ? (bx % 8) * (F.G / 8) + bx / 8 : bx; }
    F.ws = args.ws; F.out = args.out; F.ctl = (gu32*)(args.ws + WS_CTL);
    for (int u = F.tid; u < (LDS_BYTES - LDSCTL_OFF) / 4; u += NTHR) ((LAS unsigned*)(F.lds + LDSCTL_OFF))[u] = 0u;
    __syncthreads();
    XcdBarrier bar; bar.bar = (unsigned*)(F.ctl + CW_BAR) + args.li * XCD_BAR_WORDS; bar.x = 0; bar.st = nullptr;
    if (N_LAUNCHES != PER_PHASE) bar = xcd_barrier_post((unsigned*)(F.ctl + CW_BAR) + args.li * XCD_BAR_WORDS, F.MISC + 8);
#define GRID_BAR() do { if (N_LAUNCHES != PER_PHASE) xcd_barrier(bar); } while (0)
    const int lo = args.ph_lo, hi = args.ph_hi;
#define IN(k) (lo <= (k) && (k) < hi)
#define BOTH(k) (IN(k) && IN((k) + 1))
    if (IN(0)) { F.retid(); p0_prologue(F, args); if (BOTH(0)) GRID_BAR(); }
    if (IN(1)) { F.retid(); p1_fast(F, args); if (BOTH(1)) GRID_BAR(); }
    if (IN(2)) { F.retid(); lru::run<false>(F, args); if (BOTH(2)) GRID_BAR(); }
    if (IN(3)) { F.retid(); p3_fast(F, args); if (BOTH(3)) GRID_BAR(); }
    if (IN(4)) { F.retid(); p4_fast(F, args); if (BOTH(4)) GRID_BAR(); }
    if (IN(5)) { F.retid(); p5_route2(F, args); if (BOTH(5)) GRID_BAR(); }
    if (IN(6)) { F.retid(); p6_fast(F, args); if (BOTH(6)) GRID_BAR(); }
    if (IN(7)) { F.retid(); p7_fast(F, args); }
#undef IN
#undef BOTH
}

extern "C" void kernel_launch(void* const* d_in, const int* in_sizes, int n_in, void* d_out, int out_size, void* d_ws, size_t ws_size, hipStream_t stream) {
    static int grid = 0;
    if (grid == 0) {
        if (n_in != 27 || in_sizes[0] != T * DM || out_size != T * DM || ws_size < WS_END) {
            fprintf(stderr, "kernel_launch: unexpected shapes (n_in %d, in0 %d, out %d, ws %zu); nothing launched\n", n_in, n_in > 0 ? in_sizes[0] : -1, out_size, ws_size); grid = -1; return; }
        int dev = 0, cus = 0;
        if (hipGetDevice(&dev) != hipSuccess || hipDeviceGetAttribute(&cus, hipDeviceAttributeMultiprocessorCount, dev) != hipSuccess) { grid = -1; return; }
        if (hipFuncSetAttribute((const void*)fwd_kernel, hipFuncAttributeMaxDynamicSharedMemorySize, LDS_BYTES) != hipSuccess) { fprintf(stderr, "kernel_launch: hipFuncSetAttribute failed\n"); grid = -1; return; }
        (void)hipGetLastError();
        grid = cus;
    }
    if (grid < 0) return;
    if (hipMemsetAsync((char*)d_ws + WS_CTL, 0, CTL_ZERO_BYTES, stream) != hipSuccess) return;
    Args a{};
    for (int i = 0; i < 27; ++i) a.in[i] = (const float*)d_in[i];
    a.out = (float*)d_out; a.ws = (unsigned char*)d_ws;
#if PROBE_PHASE >= 0
    const int cuts[4] = {0, PROBE_PHASE + 1, PROBE_PHASE + 1, PER_PHASE};
    for (int li = 0; li < 3; ++li) {
        a.ph_lo = (li == 1) ? PROBE_PHASE : cuts[li]; a.ph_hi = cuts[li + 1]; a.li = li;
        if (a.ph_lo >= a.ph_hi) continue;
        hipLaunchKernelGGL(fwd_kernel, dim3(grid), dim3(NTHR), LDS_BYTES, stream, a);
    }
#else
    for (int li = 0; li < N_LAUNCHES; ++li) {
        a.ph_lo = (N_LAUNCHES == PER_PHASE) ? li : 0; a.ph_hi = (N_LAUNCHES == PER_PHASE) ? li + 1 : PER_PHASE; a.li = (N_LAUNCHES == PER_PHASE) ? 0 : li;
        hipLaunchKernelGGL(fwd_kernel, dim3(grid), dim3(NTHR), LDS_BYTES, stream, a);
    }
#endif
}
```
